# Optimizing an MI355X kernel written in HIP

```python
import math
import jax, jax.numpy as jnp
from jax import lax
import numpy as np

D_MODEL = 4096
BATCH = 2
SEQ = 4096
DEPTH = 4

D_FF = 3 * D_MODEL // 4
ATTN_HEADS = 8
ATTN_HEAD_DIM = 128
ATTN_V_DIM = 2 * ATTN_HEAD_DIM
ATTN_Q_BLOCK = 128
ROPE_THETA = 10000.0
GLA_HEADS = 4
GLA_K_DIM = 128
GLA_V_DIM = 256
GLA_GATE_RANK = 16
GLA_GATE_NORMALIZER = 16.0
HGRN_HEADS = 8
HGRN_K_DIM = 128
HGRN_V_DIM = 128
CHUNK = 64
NORM_EPS = 1e-6
LB_FLOOR = 1e-20

ATTN_QK_WIDTH = ATTN_HEADS * 2 * ATTN_HEAD_DIM
ATTN_WIDTH = ATTN_HEADS * ATTN_V_DIM
GLA_K_WIDTH = GLA_HEADS * GLA_K_DIM
GLA_WIDTH = GLA_HEADS * GLA_V_DIM
HGRN_K_WIDTH = HGRN_HEADS * HGRN_K_DIM
HGRN_WIDTH = HGRN_HEADS * HGRN_V_DIM

PROJ_SIZES = (
    ATTN_QK_WIDTH, ATTN_QK_WIDTH, ATTN_WIDTH,
    GLA_K_WIDTH, GLA_K_WIDTH, GLA_WIDTH, GLA_WIDTH,
    GLA_GATE_RANK, GLA_GATE_RANK,
    HGRN_K_WIDTH, HGRN_K_WIDTH, HGRN_K_WIDTH, HGRN_WIDTH, HGRN_WIDTH,
    D_MODEL, D_MODEL, D_MODEL,
)
PROJ_SPLITS = tuple(int(s) for s in np.cumsum(PROJ_SIZES)[:-1])
PROJ_TOTAL = int(sum(PROJ_SIZES))

kernel_name = "hybrid_diffattn_gla_hgrn2_macaron_encoder"


def rms_norm(x, gain):
    xf = x.astype(jnp.float32)
    y = xf * lax.rsqrt(jnp.mean(xf * xf, axis=-1, keepdims=True) + NORM_EPS)
    return (y * gain.astype(jnp.float32)).astype(x.dtype)


def swiglu_ffn(x, w_in, w_out):
    gate, up = jnp.split(x @ w_in, 2, axis=-1)
    return (jax.nn.silu(gate) * up) @ w_out


def rotary(x, positions):
    dh = x.shape[-1]
    half = dh // 2
    inv_freq = ROPE_THETA ** (-jnp.arange(half, dtype=jnp.float32) / half)
    ang = positions.astype(jnp.float32)[:, None] * inv_freq[None, :]
    cos = jnp.cos(ang)[:, None, None, :]
    sin = jnp.sin(ang)[:, None, None, :]
    xf = x.astype(jnp.float32)
    x1, x2 = xf[..., :half], xf[..., half:]
    return jnp.concatenate([x1 * cos - x2 * sin, x2 * cos + x1 * sin], axis=-1).astype(x.dtype)


def diff_attention(q, k, v, lam):
    b, s, h, _, dh = q.shape
    nb = s // ATTN_Q_BLOCK
    qb = q.reshape(b, nb, ATTN_Q_BLOCK, h, 2, dh).transpose(1, 0, 2, 3, 4, 5)
    kf = k.astype(jnp.float32)
    vf = v.astype(jnp.float32)
    scale = dh ** -0.5

    def one_block(q_blk):
        scores = jnp.einsum('bqhmd,bkhmd->bhmqk', q_blk.astype(jnp.float32), kf) * scale
        p = jax.nn.softmax(scores, axis=-1)
        a = p[:, :, 0] - lam * p[:, :, 1]
        return jnp.einsum('bhqk,bkhe->bqhe', a, vf)

    o = lax.map(one_block, qb)
    return o.transpose(1, 0, 2, 3, 4).reshape(b, s, h, -1).astype(v.dtype)


def chunked_gated_scan(q, k, v, log_f):
    b, h, s, dk = q.shape
    dv = v.shape[-1]
    n = s // CHUNK

    def chunks(t):
        return jnp.moveaxis(t.astype(jnp.float32).reshape(b, h, n, CHUNK, t.shape[-1]), 2, 0)

    mask = jnp.tril(jnp.ones((CHUNK, CHUNK), dtype=bool))[:, :, None]

    def step(state, inp):
        qc, kc, vc, gc = inp
        cum = jnp.cumsum(gc, axis=-2)
        diff = jnp.where(mask, cum[..., :, None, :] - cum[..., None, :, :], 0.0)
        decay = jnp.where(mask, jnp.exp(diff), 0.0)
        scores = jnp.einsum('bhik,bhjk,bhijk->bhij', qc, kc, decay)
        o = (jnp.einsum('bhij,bhjv->bhiv', scores, vc)
             + jnp.einsum('bhik,bhkv->bhiv', qc * jnp.exp(cum), state))
        last = cum[..., -1, :]
        state = (state * jnp.exp(last)[..., None]
                 + jnp.einsum('bhjk,bhjv->bhkv', kc * jnp.exp(last[..., None, :] - cum), vc))
        return state, o

    state0 = jnp.zeros((b, h, dk, dv), jnp.float32)
    _, o = lax.scan(step, state0, (chunks(q), chunks(k), chunks(v), chunks(log_f)))
    return jnp.moveaxis(o, 0, 2).reshape(b, h, s, dv).astype(v.dtype)


def bidirectional_scan(q, k_fwd, k_bwd, v, g_fwd, g_bwd):
    flip = lambda t: jnp.flip(t, axis=2)
    fwd = chunked_gated_scan(q, k_fwd, v, g_fwd)
    bwd = flip(chunked_gated_scan(flip(q), flip(k_bwd), flip(v), flip(g_bwd)))
    return fwd + bwd


def to_heads(t, n_heads):
    b, s, _ = t.shape
    return t.reshape(b, s, n_heads, -1).transpose(0, 2, 1, 3)


def layer_lower_bounds(logits):
    p = jax.nn.softmax(logits.astype(jnp.float32), axis=0)
    return jnp.cumsum(p, axis=0) - p[0]


def hgrn_gate(z, lb):
    zf = z.astype(jnp.float32)
    lb = jnp.clip(lb, 0.0, 1.0 - 1e-6)
    log_f = jnp.logaddexp(jnp.log(jnp.maximum(lb, LB_FLOOR)),
                          jnp.log1p(-lb) + jax.nn.log_sigmoid(zf))
    key_in = (1.0 - lb) * jax.nn.sigmoid(-zf)
    return key_in, log_f


def gla_log_gate(lr, w2, bias):
    return jax.nn.log_sigmoid((lr @ w2 + bias).astype(jnp.float32)) / GLA_GATE_NORMALIZER


def setup_inputs(seed: int = 0) -> dict:
    key = jax.random.key(seed)
    ks = jax.random.split(key, 32)
    L, D, F = DEPTH, D_MODEL, D_FF

    def w(k, shape, fan_in):
        return jax.random.normal(k, shape, jnp.float32) * (fan_in ** -0.5)

    def gain(k, shape):
        return 1.0 + 0.02 * jax.random.normal(k, shape, jnp.float32)

    def small(k, shape, s):
        return s * jax.random.normal(k, shape, jnp.float32)

    return {
        "x": jax.random.normal(ks[0], (BATCH, SEQ, D), jnp.float32),
        "ffn1_norm": gain(ks[1], (L, D)),
        "ffn1_w_in": w(ks[2], (L, D, 2 * F), D),
        "ffn1_w_out": w(ks[3], (L, F, D), F),
        "mix_norm": gain(ks[4], (L, D)),
        "w_in": w(ks[5], (L, D, PROJ_TOTAL), D),
        "attn_q_norm": gain(ks[6], (L, ATTN_HEAD_DIM)),
        "attn_k_norm": gain(ks[7], (L, ATTN_HEAD_DIM)),
        "attn_lambda": small(ks[8], (L, 4, ATTN_HEAD_DIM), 0.1),
        "attn_sub_norm": gain(ks[9], (L, ATTN_V_DIM)),
        "gla_gate_w2_fwd": w(ks[10], (L, GLA_GATE_RANK, GLA_K_WIDTH), GLA_GATE_RANK),
        "gla_gate_b_fwd": small(ks[11], (L, GLA_K_WIDTH), 0.01),
        "gla_gate_w2_bwd": w(ks[12], (L, GLA_GATE_RANK, GLA_K_WIDTH), GLA_GATE_RANK),
        "gla_gate_b_bwd": small(ks[13], (L, GLA_K_WIDTH), 0.01),
        "gla_out_norm": gain(ks[14], (L, GLA_V_DIM)),
        "hgrn_lb_fwd": small(ks[15], (L, HGRN_K_WIDTH), 0.5),
        "hgrn_lb_bwd": small(ks[16], (L, HGRN_K_WIDTH), 0.5),
        "hgrn_out_norm": gain(ks[17], (L, HGRN_V_DIM)),
        "w_branch_attn": w(ks[18], (L, ATTN_WIDTH, D), ATTN_WIDTH),
        "w_branch_gla": w(ks[19], (L, GLA_WIDTH, D), GLA_WIDTH),
        "w_branch_hgrn": w(ks[20], (L, HGRN_WIDTH, D), HGRN_WIDTH),
        "w_out": w(ks[21], (L, D, D), D),
        "ffn2_norm": gain(ks[22], (L, D)),
        "ffn2_w_in": w(ks[23], (L, D, 2 * F), D),
        "ffn2_w_out": w(ks[24], (L, F, D), F),
    }


def reference(x, ffn1_norm, ffn1_w_in, ffn1_w_out, mix_norm, w_in,
              attn_q_norm, attn_k_norm, attn_lambda, attn_sub_norm,
              gla_gate_w2_fwd, gla_gate_b_fwd, gla_gate_w2_bwd, gla_gate_b_bwd, gla_out_norm,
              hgrn_lb_fwd, hgrn_lb_bwd, hgrn_out_norm,
              w_branch_attn, w_branch_gla, w_branch_hgrn, w_out,
              ffn2_norm, ffn2_w_in, ffn2_w_out):
    b, s, _ = x.shape
    positions = jnp.arange(s, dtype=jnp.int32)
    lb_fwd_all = layer_lower_bounds(hgrn_lb_fwd)
    lb_bwd_all = layer_lower_bounds(hgrn_lb_bwd)

    for l in range(DEPTH):
        x = x + 0.5 * swiglu_ffn(rms_norm(x, ffn1_norm[l]), ffn1_w_in[l], ffn1_w_out[l])

        h = rms_norm(x, mix_norm[l])
        (a_q, a_k, a_v, g_q, g_k, g_v, g_r, g_lr_f, g_lr_b,
         h_q, h_zf, h_zb, h_i, h_g, gate_a, gate_g, gate_h) = jnp.split(h @ w_in[l], PROJ_SPLITS, axis=-1)

        q = a_q.reshape(b, s, ATTN_HEADS, 2, ATTN_HEAD_DIM)
        k = a_k.reshape(b, s, ATTN_HEADS, 2, ATTN_HEAD_DIM)
        q = rotary(rms_norm(q, attn_q_norm[l]), positions)
        k = rotary(rms_norm(k, attn_k_norm[l]), positions)
        v = a_v.reshape(b, s, ATTN_HEADS, ATTN_V_DIM)
        lam_vec = attn_lambda[l].astype(jnp.float32)
        lam_init = 0.8 - 0.6 * math.exp(-0.3 * l)
        lam = (jnp.exp(jnp.sum(lam_vec[0] * lam_vec[1]))
               - jnp.exp(jnp.sum(lam_vec[2] * lam_vec[3])) + lam_init)
        o_a = rms_norm(diff_attention(q, k, v, lam), attn_sub_norm[l]) * (1.0 - lam_init)
        y_a = o_a.reshape(b, s, ATTN_WIDTH) @ w_branch_attn[l]

        gq = to_heads(g_q, GLA_HEADS) * (GLA_K_DIM ** -0.5)
        gk = to_heads(g_k, GLA_HEADS)
        gv = to_heads(g_v, GLA_HEADS)
        gf = to_heads(gla_log_gate(g_lr_f, gla_gate_w2_fwd[l], gla_gate_b_fwd[l]), GLA_HEADS)
        gb = to_heads(gla_log_gate(g_lr_b, gla_gate_w2_bwd[l], gla_gate_b_bwd[l]), GLA_HEADS)
        o_g = bidirectional_scan(gq, gk, gk, gv, gf, gb).transpose(0, 2, 1, 3)
        o_g = rms_norm(o_g, gla_out_norm[l]).reshape(b, s, GLA_WIDTH) * jax.nn.silu(g_r)
        y_g = o_g @ w_branch_gla[l]

        k_f, logf_f = hgrn_gate(h_zf, lb_fwd_all[l])
        k_b, logf_b = hgrn_gate(h_zb, lb_bwd_all[l])
        hq = to_heads(h_q, HGRN_HEADS) * (HGRN_K_DIM ** -0.5)
        hi = to_heads(h_i, HGRN_HEADS)
        o_h = bidirectional_scan(hq, to_heads(k_f, HGRN_HEADS), to_heads(k_b, HGRN_HEADS), hi,
                                 to_heads(logf_f, HGRN_HEADS), to_heads(logf_b, HGRN_HEADS))
        o_h = rms_norm(o_h.transpose(0, 2, 1, 3), hgrn_out_norm[l]).reshape(b, s, HGRN_WIDTH) * jax.nn.silu(h_g)
        y_h = o_h @ w_branch_hgrn[l]

        merged = (jax.nn.sigmoid(gate_a) * y_a + jax.nn.sigmoid(gate_g) * y_g
                  + jax.nn.sigmoid(gate_h) * y_h)
        x = x + merged @ w_out[l]

        x = x + 0.5 * swiglu_ffn(rms_norm(x, ffn2_norm[l]), ffn2_w_in[l], ffn2_w_out[l])
    return x
```

```cpp
#include <hip/hip_runtime.h>
#include <hip/hip_bf16.h>
#include <cstdio>
#include <cstdint>
namespace pg8 {
#define PG8_LAS __attribute__((address_space(3)))
typedef unsigned short bf16_t;
typedef short bf16x8 __attribute__((ext_vector_type(8)));
typedef float f32x4 __attribute__((ext_vector_type(4)));
typedef unsigned u32x4 __attribute__((ext_vector_type(4)));
constexpr int BM = 256, BK = 64, HALF = 128, HTB = HALF * BK * 2  , STAGE_BYTES = 8 * HTB, NXCD = 8, WGM = 4;

__host__ __device__ __forceinline__ int lds_byte(int r, int c) { const int st = (r >> 4) * 2 + (c >> 5), rr = r & 15, cc = c & 31, ob = rr * 64 + cc * 2; return st * 1024 + (ob ^ (((ob >> 9) & 1) << 5)); }
__host__ __device__ __forceinline__ void stage_rc(int b, int& R, int& C) { const int st = b / 1024, sb = b % 1024, swz = sb ^ (((sb >> 9) & 1) << 5); R = (st >> 1) * 16 + swz / 64; C = (st & 1) * 32 + (swz % 64) / 2; }
__host__ __device__ __forceinline__ int perm32(int rho) { const int n = rho >> 4, i = rho & 15; return 8 * (i >> 2) + 4 * n + (i & 3); }

struct Unit { int pm, pn; };
struct Gemm { const bf16_t* A; const bf16_t* Bt; int M, N, K; };

struct StaticOrder {
    int nM, nN, nwg, G, c;
    __host__ __device__ void init(int M, int N, int G_, int c_) { nM = M / BM; nN = N / BM; nwg = nM * nN; G = G_; c = c_; }
    __host__ __device__ bool next(int i, Unit& u) const {
        const long L = (long)i * G + c; if (L >= nwg) return false;
        int wgid = (int)L; { const int q = nwg / NXCD, r = nwg % NXCD, xcd = wgid % NXCD, off = wgid / NXCD; wgid = (xcd < r ? xcd * (q + 1) : r * (q + 1) + (xcd - r) * q) + off; }
        const int nig = WGM * nN, gid = wgid / nig, fm = gid * WGM, gsz = (nM - fm) < WGM ? (nM - fm) : WGM;
        u.pm = fm + ((wgid % nig) % gsz); u.pn = (wgid % nig) / gsz; return true;
    }
    __device__ __forceinline__ void a_ready(const Unit&) const {}
    __device__ __forceinline__ void done(const Unit&) const {}
};

__device__ __forceinline__ unsigned cvt_pk_bf16(float lo, float hi) { unsigned r; asm volatile("v_cvt_pk_bf16_f32 %0, %1, %2" : "=v"(r) : "v"(lo), "v"(hi)); return r; }
typedef float f32x2 __attribute__((ext_vector_type(2)));
typedef unsigned u32x2 __attribute__((ext_vector_type(2)));
__device__ __forceinline__ float sigmoid_fast(float x) { return __builtin_amdgcn_rcpf(1.0f + __builtin_amdgcn_exp2f(-1.4426950408889634f * x)); }
__device__ __forceinline__ float bf_lo(unsigned w) { return __uint_as_float(w << 16); }
__device__ __forceinline__ float bf_hi(unsigned w) { return __uint_as_float(w & 0xffff0000u); }

struct EpiGlu {
    static constexpr bool PERM = true, AFTER_DRAIN = false, KHOOK = false;
    bf16_t* O; int ldc; const unsigned long long* ss; float inv_n, eps;
    __device__ __forceinline__ void operator()(const f32x4 (&acc)[2][2][4][2], const Unit& u, int wr, int wc, int fr, int fq) const {
        const int row0 = u.pm * BM + wr * 64 + fr, col0 = u.pn * HALF + wc * 32 + 8 * fq;
        unsigned long long sv[8];
#pragma unroll
        for (int rg = 0; rg < 8; ++rg) sv[rg] = ss[row0 + (rg >> 2) * HALF + (rg & 3) * 16];
#pragma unroll
        for (int ai = 0; ai < 2; ++ai)
#pragma unroll
            for (int m = 0; m < 4; ++m) { const int row = row0 + ai * HALF + m * 16; bf16_t* rowp = O + (size_t)row * ldc + col0;
                const float rs = __builtin_amdgcn_rsqf((float)sv[ai * 4 + m] * (1.0f / 1048576.0f) * inv_n + eps);
                f32x4 v0, v1;
#pragma unroll
                for (int j = 0; j < 4; ++j) { const float g0 = acc[ai][0][m][0][j] * rs, g1 = acc[ai][0][m][1][j] * rs;
                    v0[j] = g0 * sigmoid_fast(g0) * (acc[ai][1][m][0][j] * rs); v1[j] = g1 * sigmoid_fast(g1) * (acc[ai][1][m][1][j] * rs); }
                u32x4 w; w.x = cvt_pk_bf16(v0[0], v0[1]); w.y = cvt_pk_bf16(v0[2], v0[3]); w.z = cvt_pk_bf16(v1[0], v1[1]); w.w = cvt_pk_bf16(v1[2], v1[3]);
                *(u32x4*)rowp = w; }
    }
};
template <bool BASE_F32, bool OUT_F32, bool W8 = false> struct EpiResid {
    static constexpr bool PERM = true, AFTER_DRAIN = false, KHOOK = false;
    const float* basef; float* out; bf16_t* xb; unsigned long long* ss; int ldc; float s; unsigned char* x8;
    __device__ __forceinline__ void operator()(const f32x4 (&acc)[2][2][4][2], const Unit& u, int wr, int wc, int fr, int fq) const {
        const int row0 = u.pm * BM + wr * 64 + fr, col0 = u.pn * BM + wc * 32 + 8 * fq;
        u32x4 bw[8][2];
        if (!BASE_F32 && !W8) {
#pragma unroll
            for (int rg = 0; rg < 8; ++rg)
#pragma unroll
                for (int bj = 0; bj < 2; ++bj) bw[rg][bj] = *(const u32x4*)(xb + (size_t)(row0 + (rg >> 2) * HALF + (rg & 3) * 16) * ldc + col0 + bj * HALF);
        }
#pragma unroll
        for (int rg = 0; rg < 8; ++rg) { const int ai = rg >> 2, m = rg & 3; const int row = row0 + ai * HALF + m * 16; const size_t off = (size_t)row * ldc + col0; float q2 = 0.f;
            if (!BASE_F32 && W8 && m == 0) {
#pragma unroll
                for (int r2 = 0; r2 < 4; ++r2)
#pragma unroll
                    for (int bj = 0; bj < 2; ++bj) bw[rg + r2][bj] = *(const u32x4*)(xb + (size_t)(row0 + ai * HALF + r2 * 16) * ldc + col0 + bj * HALF);
                asm volatile("" ::: "memory"); }
#pragma unroll
            for (int bj = 0; bj < 2; ++bj) { f32x4 b0, b1;
                if (BASE_F32) { b0 = *(const f32x4*)(basef + off + bj * HALF); b1 = *(const f32x4*)(basef + off + bj * HALF + 4); }
                else { const u32x4 w = bw[rg][bj]; b0 = (f32x4){bf_lo(w.x), bf_hi(w.x), bf_lo(w.y), bf_hi(w.y)}; b1 = (f32x4){bf_lo(w.z), bf_hi(w.z), bf_lo(w.w), bf_hi(w.w)}; }
                const f32x4 o0 = b0 + acc[ai][bj][m][0] * s, o1 = b1 + acc[ai][bj][m][1] * s;
                q2 += ((o0[0] * o0[0] + o0[1] * o0[1]) + (o0[2] * o0[2] + o0[3] * o0[3])) + ((o1[0] * o1[0] + o1[1] * o1[1]) + (o1[2] * o1[2] + o1[3] * o1[3]));
                if (OUT_F32) { *(f32x4*)(out + off + bj * HALF) = o0; *(f32x4*)(out + off + bj * HALF + 4) = o1; }
                else { u32x4 w; w.x = cvt_pk_bf16(o0[0], o0[1]); w.y = cvt_pk_bf16(o0[2], o0[3]); w.z = cvt_pk_bf16(o1[0], o1[1]); w.w = cvt_pk_bf16(o1[2], o1[3]); *(u32x4*)(xb + off + bj * HALF) = w; }
                if (W8) { int lo = __builtin_amdgcn_cvt_pk_fp8_f32(o0[0], o0[1], 0, false); lo = __builtin_amdgcn_cvt_pk_fp8_f32(o0[2], o0[3], lo, true);
                    int hi = __builtin_amdgcn_cvt_pk_fp8_f32(o1[0], o1[1], 0, false); hi = __builtin_amdgcn_cvt_pk_fp8_f32(o1[2], o1[3], hi, true);
                    *(u32x2*)(x8 + off + bj * HALF) = (u32x2){(unsigned)lo, (unsigned)hi}; } }
            if (!OUT_F32) { q2 += __shfl_xor(q2, 16); q2 += __shfl_xor(q2, 32);
                if (fq == 0) __hip_atomic_fetch_add(ss + row, (unsigned long long)(q2 * 1048576.0f + 0.5f), __ATOMIC_RELAXED, __HIP_MEMORY_SCOPE_AGENT); }
        }
    }
};
struct EpiBf16Plain {
    static constexpr bool PERM = true, AFTER_DRAIN = false, KHOOK = false;
    bf16_t* O; int ldc; const unsigned long long* ss; float inv_n, eps; bf16_t* O2; int ld2, t0, t1; float cs;
    __device__ __forceinline__ void operator()(const f32x4 (&acc)[2][2][4][2], const Unit& u, int wr, int wc, int fr, int fq) const {
        const bool redir = u.pn >= t0 && u.pn < t1;
        bf16_t* base = redir ? O2 : O; const int ld = redir ? ld2 : ldc;
        const int row0 = u.pm * BM + wr * 64 + fr, col0 = (redir ? u.pn - t0 : u.pn) * BM + wc * 32 + 8 * fq;
        unsigned long long sv[8];
#pragma unroll
        for (int rg = 0; rg < 8; ++rg) sv[rg] = ss[row0 + (rg >> 2) * HALF + (rg & 3) * 16];
#pragma unroll
        for (int ai = 0; ai < 2; ++ai)
#pragma unroll
            for (int m = 0; m < 4; ++m) { const int row = row0 + ai * HALF + m * 16; bf16_t* rowp = base + (size_t)row * ld + col0;
                const float rs = __builtin_amdgcn_rsqf((float)sv[ai * 4 + m] * (1.0f / 1048576.0f) * inv_n + eps) * cs;
#pragma unroll
                for (int bj = 0; bj < 2; ++bj) { const f32x4 v0 = acc[ai][bj][m][0] * rs, v1 = acc[ai][bj][m][1] * rs;
                    u32x4 w; w.x = cvt_pk_bf16(v0[0], v0[1]); w.y = cvt_pk_bf16(v0[2], v0[3]); w.z = cvt_pk_bf16(v1[0], v1[1]); w.w = cvt_pk_bf16(v1[2], v1[3]);
                    *(u32x4*)(rowp + bj * HALF) = w; } }
    }
};
struct EpiGate3 {
    static constexpr bool PERM = true, AFTER_DRAIN = false, KHOOK = true;
    const bf16_t* G; int ldg; int goff_g, goff_h; bf16_t* Mb; int ldc; int t1, t2;
    static __device__ __forceinline__ float em(float x) { return __builtin_amdgcn_exp2f(-1.4426950408889634f * fminf(fmaxf(x, -30.0f), 30.0f)); }
    __device__ __forceinline__ void khook(f32x4 (&acc)[2][2][4][2], const Unit& u, bool second, int wr, int wc, int fr, int fq) const {
        const int row0 = u.pm * BM + wr * 64 + fr, col0 = u.pn * BM + wc * 32 + 8 * fq;
        const bf16_t* gnum = G + (second ? goff_g : 0) + (size_t)row0 * ldg + col0;
        const bf16_t* gden = G + (second ? goff_h : goff_g) + (size_t)row0 * ldg + col0;
        u32x4 cn[2], cd[2], nn[2], nd[2];
#pragma unroll
        for (int bj = 0; bj < 2; ++bj) { cn[bj] = *(const u32x4*)(gnum + bj * HALF); cd[bj] = *(const u32x4*)(gden + bj * HALF); }
#pragma unroll
        for (int rg = 0; rg < 8; ++rg) { const int ai = rg >> 2, m = rg & 3;
            if (rg < 7) { const size_t ro = (size_t)(((rg + 1) >> 2) * HALF + ((rg + 1) & 3) * 16) * ldg;
#pragma unroll
                for (int bj = 0; bj < 2; ++bj) { nn[bj] = *(const u32x4*)(gnum + ro + bj * HALF); nd[bj] = *(const u32x4*)(gden + ro + bj * HALF); } }
            asm volatile("" ::: "memory");
#pragma unroll
            for (int bj = 0; bj < 2; ++bj) { const unsigned an[4] = {cn[bj].x, cn[bj].y, cn[bj].z, cn[bj].w}, ad[4] = {cd[bj].x, cd[bj].y, cd[bj].z, cd[bj].w};
#pragma unroll
                for (int p = 0; p < 4; ++p) {
                    const float r0 = (1.0f + em(bf_lo(ad[p]))) * __builtin_amdgcn_rcpf(1.0f + em(bf_lo(an[p]))), r1 = (1.0f + em(bf_hi(ad[p]))) * __builtin_amdgcn_rcpf(1.0f + em(bf_hi(an[p])));
                    acc[ai][bj][m][p >> 1][2 * (p & 1)] *= r0; acc[ai][bj][m][p >> 1][2 * (p & 1) + 1] *= r1; } }
#pragma unroll
            for (int bj = 0; bj < 2; ++bj) { cn[bj] = nn[bj]; cd[bj] = nd[bj]; } }
    }
    __device__ __forceinline__ void operator()(const f32x4 (&acc)[2][2][4][2], const Unit& u, int wr, int wc, int fr, int fq) const {
        const int row0 = u.pm * BM + wr * 64 + fr, col0 = u.pn * BM + wc * 32 + 8 * fq;
        const bf16_t* gh = G + goff_h + (size_t)row0 * ldg + col0;
        u32x4 cg[2], ng[2];
#pragma unroll
        for (int bj = 0; bj < 2; ++bj) cg[bj] = *(const u32x4*)(gh + bj * HALF);
#pragma unroll
        for (int rg = 0; rg < 8; ++rg) { const int ai = rg >> 2, m = rg & 3; const size_t ro = (size_t)(ai * HALF + m * 16); bf16_t* rowp = Mb + (size_t)(row0 + ro) * ldc + col0;
            if (rg < 7) { const size_t rn = (size_t)(((rg + 1) >> 2) * HALF + ((rg + 1) & 3) * 16) * ldg;
#pragma unroll
                for (int bj = 0; bj < 2; ++bj) ng[bj] = *(const u32x4*)(gh + rn + bj * HALF); }
            asm volatile("" ::: "memory");
#pragma unroll
            for (int bj = 0; bj < 2; ++bj) { const unsigned ag[4] = {cg[bj].x, cg[bj].y, cg[bj].z, cg[bj].w};
                float o[8];
#pragma unroll
                for (int p = 0; p < 4; ++p) { o[2 * p] = acc[ai][bj][m][p >> 1][2 * (p & 1)] * __builtin_amdgcn_rcpf(1.0f + em(bf_lo(ag[p]))); o[2 * p + 1] = acc[ai][bj][m][p >> 1][2 * (p & 1) + 1] * __builtin_amdgcn_rcpf(1.0f + em(bf_hi(ag[p]))); }
                u32x4 w; w.x = cvt_pk_bf16(o[0], o[1]); w.y = cvt_pk_bf16(o[2], o[3]); w.z = cvt_pk_bf16(o[4], o[5]); w.w = cvt_pk_bf16(o[6], o[7]);
                *(u32x4*)(rowp + bj * HALF) = w; }
#pragma unroll
            for (int bj = 0; bj < 2; ++bj) cg[bj] = ng[bj]; }
    }
};

typedef int pg8_v8i __attribute__((ext_vector_type(8)));
typedef int pg8_v4i __attribute__((ext_vector_type(4)));
__device__ __forceinline__ pg8_v8i pg8_cat(bf16x8 lo, bf16x8 hi) { const pg8_v4i a = __builtin_bit_cast(pg8_v4i, lo), b = __builtin_bit_cast(pg8_v4i, hi); return (pg8_v8i){a[0], a[1], a[2], a[3], b[0], b[1], b[2], b[3]}; }
template <class Epi, class Sched, bool ALIGN_EPI = false, bool SP2 = false, bool FP8 = false>
__device__ __forceinline__ void gemm_phase(PG8_LAS unsigned char* lds, const Gemm g, const Sched& S, const Epi& E) {
    int tid_ = threadIdx.x; asm volatile("" : "+v"(tid_));
    const int tid = tid_, wid = __builtin_amdgcn_readfirstlane(tid >> 6), lane = tid & 63, wr = wid >> 2, wc = wid & 3, fr = lane & 15, fq = lane >> 4;
    const int K = g.K, nt = K / BK;
    unsigned voffA[2], voffB[2];
#pragma unroll
    for (int i = 0; i < 2; ++i) { int R, C; stage_rc(tid * 16 + i * 8192, R, C); const int Rb = Epi::PERM ? ((R & ~31) + perm32(R & 31)) : R;
        voffA[i] = (unsigned)(R * K + C) * 2u; voffB[i] = (unsigned)(Rb * K + C) * 2u; }
    const size_t kstep = (size_t)(BK * 2);
    const size_t hstep = (size_t)HALF * K * 2;
    const size_t tstep = 2 * hstep;
    const unsigned ldsw = (unsigned)wid * 1024u;
    const int aoff = lds_byte(wr * 64 + fr, fq * 8), boff = lds_byte(wc * 32 + fr, fq * 8);
#define PG8_SA(b, h) (((b) * 2 + (h)) * HTB)
#define PG8_SB(b, h) ((4 + (b) * 2 + (h)) * HTB)
#define PG8_STAGE(bufoff, gbase, voff) do { _Pragma("unroll") for (int _i = 0; _i < 2; ++_i) \
        __builtin_amdgcn_global_load_lds((const unsigned*)((const char*)(gbase) + (voff)[_i]), (PG8_LAS unsigned*)(lds + (bufoff) + ldsw + _i * 8192), 16, 0, 0); } while (0)
#define PG8_LDA(dst, b, h) do { _Pragma("unroll") for (int m = 0; m < 4; ++m) _Pragma("unroll") for (int k = 0; k < 2; ++k) dst[m][k] = *(const PG8_LAS bf16x8*)(lds + PG8_SA(b, h) + aoff + m * 2048 + k * 1024); } while (0)
#define PG8_LDB(dst, b, h) do { _Pragma("unroll") for (int n = 0; n < 2; ++n) _Pragma("unroll") for (int k = 0; k < 2; ++k) dst[n][k] = *(const PG8_LAS bf16x8*)(lds + PG8_SB(b, h) + boff + n * 2048 + k * 1024); } while (0)
#define PG8_MMA(ai, bj, At, Bt) do { __builtin_amdgcn_s_setprio(1); if constexpr (FP8) { _Pragma("unroll") for (int m = 0; m < 4; ++m) _Pragma("unroll") for (int n = 0; n < 2; ++n) \
        { const pg8_v8i a8_ = pg8_cat(Bt[n][0], Bt[n][1]), b8_ = pg8_cat(At[m][0], At[m][1]);   \
          asm volatile("v_mfma_scale_f32_16x16x128_f8f6f4 %0, %1, %2, %0, %3, %3 op_sel_hi:[0,0,0]" : "+v"(acc[ai][bj][m][n]) : "v"(a8_), "v"(b8_), "v"(pg8_one)); } } else { \
        _Pragma("unroll") for (int m = 0; m < 4; ++m) _Pragma("unroll") for (int n = 0; n < 2; ++n) _Pragma("unroll") for (int k = 0; k < 2; ++k) \
        acc[ai][bj][m][n] = __builtin_amdgcn_mfma_f32_16x16x32_bf16(Bt[n][k], At[m][k], acc[ai][bj][m][n], 0, 0, 0); } __builtin_amdgcn_s_setprio(0); } while (0)
#define PG8_WAIT_V(n) asm volatile("s_waitcnt vmcnt(" #n ")" ::: "memory")
#define PG8_WAIT_L(n) asm volatile("s_waitcnt lgkmcnt(" #n ")" ::: "memory")
#define PG8_BAR __builtin_amdgcn_s_barrier()
#define PG8_SCHED __builtin_amdgcn_sched_barrier(0)
    Unit cur, nxt; int ui = 0;
    if (!S.next(0, cur)) return;
    const int pg8_one = 0x7f7f7f7f;
    f32x4 acc[2][2][4][2];
#pragma unroll
    for (int a = 0; a < 2; ++a)
#pragma unroll
        for (int b = 0; b < 2; ++b)
#pragma unroll
            for (int m = 0; m < 4; ++m)
#pragma unroll
                for (int n = 0; n < 2; ++n) acc[a][b][m][n] = (f32x4){0.f, 0.f, 0.f, 0.f};
    bf16x8 At[4][2], B0[2][2], B1[2][2];
    const char* cA = (const char*)g.A + (size_t)cur.pm * tstep; const char* cB = (const char*)g.Bt + (size_t)cur.pn * tstep;
    S.a_ready(cur);
    if constexpr (SP2) {
        PG8_STAGE(PG8_SB(0, 0), cB, voffB); PG8_STAGE(PG8_SB(0, 1), cB + hstep, voffB); PG8_STAGE(PG8_SA(0, 0), cA, voffA); PG8_STAGE(PG8_SA(0, 1), cA + hstep, voffA);
        if (wr == 1) PG8_BAR;
        PG8_WAIT_V(2); PG8_BAR;
        PG8_STAGE(PG8_SB(1, 0), cB + kstep, voffB); PG8_STAGE(PG8_SA(1, 0), cA + kstep, voffA); PG8_STAGE(PG8_SB(1, 1), cB + hstep + kstep, voffB);
        PG8_WAIT_V(6); PG8_BAR;
    } else {
        PG8_STAGE(PG8_SB(0, 0), cB, voffB); PG8_STAGE(PG8_SA(0, 0), cA, voffA); PG8_STAGE(PG8_SB(0, 1), cB + hstep, voffB); PG8_STAGE(PG8_SA(0, 1), cA + hstep, voffA);
        if (wr == 1) PG8_BAR;
        PG8_WAIT_V(4); PG8_BAR;
        PG8_STAGE(PG8_SB(1, 0), cB + kstep, voffB); PG8_STAGE(PG8_SA(1, 0), cA + kstep, voffA); PG8_STAGE(PG8_SB(1, 1), cB + hstep + kstep, voffB);
        PG8_WAIT_V(6); PG8_BAR;
    }
    for (;;) {
        const bool has_next = S.next(ui + 1, nxt);
        const char* nA = has_next ? (const char*)g.A + (size_t)nxt.pm * tstep : cA; const char* nB = has_next ? (const char*)g.Bt + (size_t)nxt.pn * tstep : cB;
        for (int t = 0; t < nt; t += 2) {
            const bool last = (t == nt - 2);
            const char* a1 = cA + (size_t)(t + 1) * kstep;
            const char* a2 = last ? nA : cA + (size_t)(t + 2) * kstep; const char* b2 = last ? nB : cB + (size_t)(t + 2) * kstep;
            const char* a3 = a2 + kstep; const char* b3 = b2 + kstep;
            if (last && has_next) S.a_ready(nxt);
            if constexpr (Epi::KHOOK) { if (t == E.t1 || t == E.t2) E.khook(acc, cur, t == E.t2, wr, wc, fr, fq); }
            if constexpr (SP2) {
            PG8_LDB(B0, 0, 0); PG8_LDB(B1, 0, 1); PG8_SCHED; PG8_LDA(At, 0, 0); PG8_STAGE(PG8_SA(1, 1), a1 + hstep, voffA);
            PG8_WAIT_V(8); PG8_WAIT_L(0); PG8_BAR; PG8_MMA(0, 0, At, B0); PG8_MMA(0, 1, At, B1); PG8_BAR; PG8_SCHED;
            PG8_LDA(At, 0, 1); PG8_STAGE(PG8_SB(0, 0), b2, voffB); PG8_STAGE(PG8_SB(0, 1), b2 + hstep, voffB); PG8_STAGE(PG8_SA(0, 0), a2, voffA);
            PG8_WAIT_V(8); PG8_WAIT_L(0); PG8_BAR; PG8_MMA(1, 0, At, B0); PG8_MMA(1, 1, At, B1); PG8_BAR; PG8_SCHED;
            PG8_LDB(B0, 1, 0); PG8_LDB(B1, 1, 1); PG8_SCHED; PG8_LDA(At, 1, 0); PG8_STAGE(PG8_SA(0, 1), a2 + hstep, voffA);
            PG8_WAIT_V(8); PG8_WAIT_L(0); PG8_BAR; PG8_MMA(0, 0, At, B0); PG8_MMA(0, 1, At, B1); PG8_BAR; PG8_SCHED;
            PG8_LDA(At, 1, 1); PG8_STAGE(PG8_SB(1, 0), b3, voffB); PG8_STAGE(PG8_SB(1, 1), b3 + hstep, voffB); PG8_STAGE(PG8_SA(1, 0), a3, voffA);
            PG8_WAIT_V(8); PG8_WAIT_L(0); PG8_BAR; PG8_MMA(1, 0, At, B0); PG8_MMA(1, 1, At, B1); PG8_BAR; PG8_SCHED;
            } else {
            PG8_LDB(B0, 0, 0); PG8_SCHED; PG8_LDA(At, 0, 0); PG8_STAGE(PG8_SA(1, 1), a1 + hstep, voffA);
            PG8_WAIT_L(8); PG8_BAR; PG8_WAIT_L(0); PG8_MMA(0, 0, At, B0); PG8_BAR; PG8_SCHED;
            PG8_LDB(B1, 0, 1); PG8_STAGE(PG8_SB(0, 0), b2, voffB);
            PG8_BAR; PG8_WAIT_L(0); PG8_MMA(0, 1, At, B1); PG8_BAR;
            PG8_LDA(At, 0, 1); PG8_STAGE(PG8_SA(0, 0), a2, voffA);
            PG8_BAR; PG8_WAIT_L(0); PG8_MMA(1, 0, At, B0); PG8_BAR; PG8_SCHED;
            PG8_STAGE(PG8_SB(0, 1), b2 + hstep, voffB);
            PG8_WAIT_V(6); PG8_BAR; PG8_MMA(1, 1, At, B1); PG8_BAR;
            PG8_LDB(B0, 1, 0); PG8_SCHED; PG8_LDA(At, 1, 0); PG8_STAGE(PG8_SA(0, 1), a2 + hstep, voffA);
            PG8_WAIT_L(8); PG8_BAR; PG8_WAIT_L(0); PG8_MMA(0, 0, At, B0); PG8_BAR; PG8_SCHED;
            PG8_LDB(B1, 1, 1); PG8_STAGE(PG8_SB(1, 0), b3, voffB);
            PG8_BAR; PG8_WAIT_L(0); PG8_MMA(0, 1, At, B1); PG8_BAR;
            PG8_LDA(At, 1, 1); PG8_STAGE(PG8_SA(1, 0), a3, voffA);
            PG8_BAR; PG8_WAIT_L(0); PG8_MMA(1, 0, At, B0); PG8_BAR; PG8_SCHED;
            PG8_STAGE(PG8_SB(1, 1), b3 + hstep, voffB);
            PG8_WAIT_V(6); PG8_BAR; PG8_MMA(1, 1, At, B1); PG8_BAR;
            }
        }
        if constexpr (ALIGN_EPI) { if (wr == 0) PG8_BAR; }
        if constexpr (!Epi::AFTER_DRAIN) { E(acc, cur, wr, wc, fr, fq); S.done(cur); }
        if (!has_next) break;
#pragma unroll
        for (int a = 0; a < 2; ++a)
#pragma unroll
            for (int b = 0; b < 2; ++b)
#pragma unroll
                for (int m = 0; m < 4; ++m)
#pragma unroll
                    for (int n = 0; n < 2; ++n) acc[a][b][m][n] = (f32x4){0.f, 0.f, 0.f, 0.f};
        cur = nxt; cA = nA; cB = nB; ++ui;
        if constexpr (ALIGN_EPI) { if (wr == 1) PG8_BAR; }
    }
    PG8_WAIT_V(0);
    if constexpr (!ALIGN_EPI) { if (wr == 0) PG8_BAR; }
    PG8_BAR;
    if constexpr (Epi::AFTER_DRAIN) { E.fused(acc, cur, wr, wc, fr, fq, lds, wid, lane); S.done(cur); }
#undef PG8_SA
#undef PG8_SB
#undef PG8_STAGE
#undef PG8_LDA
#undef PG8_LDB
#undef PG8_MMA
#undef PG8_WAIT_V
#undef PG8_WAIT_L
#undef PG8_BAR
#undef PG8_SCHED
}
}
namespace att {
using bf16 = __hip_bfloat16;
constexpr int   D = 128, NW = 8, QBLK = 32, KVBLK = 64;
constexpr float SCALE = 0.088388347648318440f;
constexpr float THR = 8.f;
constexpr int SDEPTH = 1;
constexpr int LDQ = 2048, LDK = 2048, LDO = 2048;
constexpr size_t SHM_V = KVBLK * D * 2, SHM_K = KVBLK * D * 2, SHM_ATTN = 2 * SHM_V + 2 * SHM_K + NW * 64 * 4;
using bf16x8 = __attribute__((ext_vector_type(8))) short;
using s16x4  = __attribute__((ext_vector_type(4))) short;
using f32x16 = __attribute__((ext_vector_type(16))) float;
using f32x8  = __attribute__((ext_vector_type(8))) float;
using u32x4  = __attribute__((ext_vector_type(4))) unsigned;
#define KSWZ(row, colB) ((row) * 256 + ((colB) ^ (((row) & 7) << 4)))
#define SBAR() __builtin_amdgcn_sched_barrier(0)
__device__ __forceinline__ int crow(int r, int hi) { return (r & 3) + 8 * (r >> 2) + 4 * hi; }
__device__ __forceinline__ unsigned cvtpk(float lo, float hi) {
  unsigned r; asm volatile("v_cvt_pk_bf16_f32 %0, %1, %2" : "=v"(r) : "v"(lo), "v"(hi)); return r;
}
template <typename TIn> struct Stage;
template <> struct Stage<bf16>  { using T = bf16x8;
  __device__ static __forceinline__ T ld8(const bf16* p) { return *reinterpret_cast<const bf16x8*>(p); }
  __device__ static __forceinline__ bf16x8 tobf(T x) { return x; } };
template <> struct Stage<float> { using T = f32x8;
  __device__ static __forceinline__ T ld8(const float* p) { return *reinterpret_cast<const f32x8*>(p); }
  __device__ static __forceinline__ bf16x8 tobf(T x) {
    u32x4 w = {cvtpk(x[0], x[1]), cvtpk(x[2], x[3]), cvtpk(x[4], x[5]), cvtpk(x[6], x[7])}; return *reinterpret_cast<bf16x8*>(&w); } };

__device__ __forceinline__ void partialSM(f32x16& p0, f32x16& p1, float& m_reg, float& mn, float& alpha) {
  constexpr float C = SCALE * 1.4426950408889634f;
  float pmax = p0[0]; for (int r = 1; r < 16; ++r) pmax = fmaxf(pmax, p0[r]); for (int r = 0; r < 16; ++r) pmax = fmaxf(pmax, p1[r]);
  { auto rr = __builtin_amdgcn_permlane32_swap(__float_as_uint(pmax), __float_as_uint(pmax), false, false);
    pmax = fmaxf(__uint_as_float(rr[0]), __uint_as_float(rr[1])); }
  if (__builtin_expect(__all(pmax - m_reg <= THR / SCALE), 1)) { mn = m_reg; alpha = 1.f; }
  else { mn = fmaxf(m_reg, pmax); alpha = __builtin_amdgcn_exp2f((m_reg - mn) * C); m_reg = mn; }
  float mnC = -mn * C;
  for (int r = 0; r < 16; ++r) p0[r] = fmaf(p0[r], C, mnC); for (int r = 0; r < 16; ++r) p1[r] = fmaf(p1[r], C, mnC);
  for (int r = 0; r < 16; ++r) p0[r] = __builtin_amdgcn_exp2f(p0[r]);
}
__device__ __forceinline__ void finishSM(f32x16& p0, f32x16& p1, float alpha, float& l_reg, bf16x8& pa0, bf16x8& pa1, bf16x8& pa2, bf16x8& pa3) {
  for (int r = 0; r < 16; ++r) p1[r] = __builtin_amdgcn_exp2f(p1[r]);
  float ps = 0; for (int r = 0; r < 16; ++r) ps += p0[r]; for (int r = 0; r < 16; ++r) ps += p1[r];
  { auto rr = __builtin_amdgcn_permlane32_swap(__float_as_uint(ps), __float_as_uint(ps), false, false);
    ps = __uint_as_float(rr[0]) + __uint_as_float(rr[1]); }
  l_reg = l_reg * alpha + ps;
#define PK4(P, BASE, OUT) do { unsigned a0 = cvtpk(P[BASE + 0], P[BASE + 1]), a1 = cvtpk(P[BASE + 2], P[BASE + 3]);   \
    unsigned b0 = cvtpk(P[BASE + 4], P[BASE + 5]), b1 = cvtpk(P[BASE + 6], P[BASE + 7]);                              \
    auto r0 = __builtin_amdgcn_permlane32_swap(a0, b0, false, false); auto r1 = __builtin_amdgcn_permlane32_swap(a1, b1, false, false); \
    u32x4 w = {r0[0], r1[0], r0[1], r1[1]}; OUT = *reinterpret_cast<bf16x8*>(&w); } while (0)
  PK4(p0, 0, pa0); PK4(p0, 8, pa1); PK4(p1, 0, pa2); PK4(p1, 8, pa3);
#undef PK4
}
__device__ __forceinline__ void qkt(f32x16& p0, f32x16& p1, const bf16* Ks, const bf16x8* qr, int r32, int hi) {
  p0 = f32x16{}; p1 = f32x16{};
  for (int d0 = 0; d0 < 8; ++d0) { int cb = (d0 * 16 + hi * 8) * 2;
    bf16x8 b0 = *reinterpret_cast<const bf16x8*>((const char*)Ks + KSWZ(r32, cb));
    bf16x8 b1 = *reinterpret_cast<const bf16x8*>((const char*)Ks + KSWZ(32 + r32, cb));
    p0 = __builtin_amdgcn_mfma_f32_32x32x16_bf16(b0, qr[d0], p0, 0, 0, 0);
    p1 = __builtin_amdgcn_mfma_f32_32x32x16_bf16(b1, qr[d0], p1, 0, 0, 0); }
}
__device__ __forceinline__ int v_st(int k, int c) { const int kk = (k & ~0xC) | ((k & 4) << 1) | ((k & 8) >> 1); return ((kk >> 3) * 4 + (c >> 5)) * 512 + ((kk & 7) * 32 + (c & 31)) * 2; }
__device__ __forceinline__ int v_rd_base(int lane) { return ((lane & 3) << 3) | (((lane >> 2) & 3) << 6) | (((lane >> 4) & 1) << 5) | (((lane >> 5) & 1) << 8); }
constexpr int v_rd_off(int d0, int ks, int half) { return d0 * 512 + ks * 4096 + half * 2048; }
template <int OFF> __device__ __forceinline__ s16x4 tr_read(int vb) {
  s16x4 r; asm volatile("ds_read_b64_tr_b16 %0, %1 offset:%2" : "=&v"(r) : "v"(vb), "i"(OFF) : "memory"); return r;
}
template <int D0> __device__ __forceinline__ void pv_one(f32x16& od, int vb, bf16x8 pa0, bf16x8 pa1, bf16x8 pa2, bf16x8 pa3) {
  const s16x4 l0 = tr_read<v_rd_off(D0, 0, 0)>(vb), h0 = tr_read<v_rd_off(D0, 0, 1)>(vb), l1 = tr_read<v_rd_off(D0, 1, 0)>(vb), h1 = tr_read<v_rd_off(D0, 1, 1)>(vb);
  const s16x4 l2 = tr_read<v_rd_off(D0, 2, 0)>(vb), h2 = tr_read<v_rd_off(D0, 2, 1)>(vb), l3 = tr_read<v_rd_off(D0, 3, 0)>(vb), h3 = tr_read<v_rd_off(D0, 3, 1)>(vb);
  asm volatile("s_waitcnt lgkmcnt(0)" ::: "memory"); SBAR();
#define PK(L, H) (bf16x8){L[0], L[1], L[2], L[3], H[0], H[1], H[2], H[3]}
  od = __builtin_amdgcn_mfma_f32_32x32x16_bf16(pa0, PK(l0, h0), od, 0, 0, 0);
  od = __builtin_amdgcn_mfma_f32_32x32x16_bf16(pa1, PK(l1, h1), od, 0, 0, 0);
  od = __builtin_amdgcn_mfma_f32_32x32x16_bf16(pa2, PK(l2, h2), od, 0, 0, 0);
  od = __builtin_amdgcn_mfma_f32_32x32x16_bf16(pa3, PK(l3, h3), od, 0, 0, 0);
#undef PK
}
__device__ __forceinline__ void pv_d0(f32x16* o, int vb, bf16x8 pa0, bf16x8 pa1, bf16x8 pa2, bf16x8 pa3) {
  pv_one<0>(o[0], vb, pa0, pa1, pa2, pa3); pv_one<1>(o[1], vb, pa0, pa1, pa2, pa3); pv_one<2>(o[2], vb, pa0, pa1, pa2, pa3); pv_one<3>(o[3], vb, pa0, pa1, pa2, pa3);
}

template <typename TQ>
__device__ __forceinline__ void attn_dense_body(const TQ* __restrict__ Qb, const bf16* __restrict__ Kh, const bf16* __restrict__ Vh,
                                                bf16* __restrict__ Ob, int seq, char* lds) {
  using St = Stage<bf16>; using SQ = Stage<TQ>;
  int tid_ = threadIdx.x; asm volatile("" : "+v"(tid_));
  const int tid = tid_, wid = tid >> 6, lane = tid & 63, r32 = lane & 31, hi = lane >> 5;
  bf16* V_lds = (bf16*)lds; bf16* K_lds = (bf16*)(lds + 2 * SHM_V);
  float* ws = (float*)(lds + 2 * SHM_V + 2 * SHM_K) + wid * 64; float* li_l = ws; float* al_l = ws + 32;
  float m_reg = -1e30f, l_reg = 0; f32x16 o[4] = {}; bf16x8 qr[8];
  const TQ* Qw = Qb + (long)(wid * QBLK + r32) * LDQ + hi * 8;
#pragma unroll
  for (int d0 = 0; d0 < 8; ++d0) qr[d0] = SQ::tobf(SQ::ld8(Qw + d0 * 16));
  const int sr = tid >> 4, sc = (tid & 15) * 8, vst0 = v_st(sr, sc), vst1 = v_st(32 + sr, sc);
  const int vb0 = (int)(uintptr_t)V_lds + v_rd_base(lane);
  struct { typename St::T vs0, vs1, ks0, ks1; } sr_[SDEPTH];
#define SLOAD(i, k0) do { sr_[i].vs0 = St::ld8(&Vh[(long)((k0) + sr) * LDK + sc]); sr_[i].vs1 = St::ld8(&Vh[(long)((k0) + 32 + sr) * LDK + sc]); \
    sr_[i].ks0 = St::ld8(&Kh[(long)((k0) + sr) * LDK + sc]); sr_[i].ks1 = St::ld8(&Kh[(long)((k0) + 32 + sr) * LDK + sc]); } while (0)
#define SWRITE(b, i) do { *(bf16x8*)((char*)V_lds + (b) * SHM_V + vst0) = St::tobf(sr_[i].vs0);          \
    *(bf16x8*)((char*)V_lds + (b) * SHM_V + vst1) = St::tobf(sr_[i].vs1); int kc = sc * 2;               \
    *(bf16x8*)((char*)K_lds + (b) * SHM_K + KSWZ(sr, kc)) = St::tobf(sr_[i].ks0);                       \
    *(bf16x8*)((char*)K_lds + (b) * SHM_K + KSWZ(32 + sr, kc)) = St::tobf(sr_[i].ks1); } while (0)
#define SWAIT() do { if constexpr (SDEPTH == 2) asm volatile("s_waitcnt vmcnt(4)" ::: "memory"); else asm volatile("s_waitcnt vmcnt(0)" ::: "memory"); } while (0)
#define RESC(a) do { if (__any((a) < 1.f)) { if (hi == 0) al_l[r32] = (a); asm volatile("s_waitcnt lgkmcnt(0)" ::: "memory"); \
    for (int d = 0; d < 4; ++d) for (int r = 0; r < 16; ++r) o[d][r] *= al_l[crow(r, hi)]; } } while (0)
  f32x16 pA0, pA1, pB0, pB1; float mnA, mnB, alA, alB; bf16x8 pa0, pa1, pa2, pa3; const int NT = seq / KVBLK;
  constexpr int SE = 0, SO = SDEPTH - 1;
  SLOAD(SE, 0); asm volatile("s_waitcnt vmcnt(0)" ::: "memory"); SWRITE(0, SE); __syncthreads();
  qkt(pA0, pA1, K_lds, qr, r32, hi); partialSM(pA0, pA1, m_reg, mnA, alA);
  SLOAD(SO, KVBLK); if constexpr (SDEPTH == 2) { if (2 < NT) SLOAD(SE, 2 * KVBLK); }
  SWAIT(); SWRITE(1, SO); __syncthreads();
  for (int j = 1; j + 1 < NT; j += 2) {
    SBAR(); qkt(pB0, pB1, (bf16*)((char*)K_lds + SHM_K), qr, r32, hi);
    finishSM(pA0, pA1, alA, l_reg, pa0, pa1, pa2, pa3); SBAR();
    SLOAD(SO, (j + SDEPTH) * KVBLK); SBAR();
    pv_d0(o, vb0, pa0, pa1, pa2, pa3); partialSM(pB0, pB1, m_reg, mnB, alB);
    __syncthreads(); SWAIT(); SWRITE(0, SE);
    RESC(alB); __syncthreads();
    SBAR(); qkt(pA0, pA1, K_lds, qr, r32, hi);
    finishSM(pB0, pB1, alB, l_reg, pa0, pa1, pa2, pa3); SBAR();
    if (SDEPTH == 1 || j + 3 < NT) SLOAD(SE, (j + 1 + SDEPTH) * KVBLK); SBAR();
    pv_d0(o, vb0 + (int)SHM_V, pa0, pa1, pa2, pa3); partialSM(pA0, pA1, m_reg, mnA, alA);
    __syncthreads(); SWAIT(); SWRITE(1, SO);
    RESC(alA); __syncthreads();
  }
  SBAR(); qkt(pB0, pB1, (bf16*)((char*)K_lds + SHM_K), qr, r32, hi);
  finishSM(pA0, pA1, alA, l_reg, pa0, pa1, pa2, pa3); SBAR();
  pv_d0(o, vb0, pa0, pa1, pa2, pa3); partialSM(pB0, pB1, m_reg, mnB, alB);
  __syncthreads(); RESC(alB);
  finishSM(pB0, pB1, alB, l_reg, pa0, pa1, pa2, pa3); SBAR();
  pv_d0(o, vb0 + (int)SHM_V, pa0, pa1, pa2, pa3);
  if (hi == 0) li_l[r32] = l_reg; asm volatile("s_waitcnt lgkmcnt(0)" ::: "memory");
  float rli[16];
#pragma unroll
  for (int r = 0; r < 16; ++r) rli[r] = __builtin_amdgcn_rcpf(li_l[crow(r, hi)]);
  bf16* Ow = Ob + (long)(wid * QBLK) * LDO;
#pragma unroll
  for (int r = 0; r < 16; ++r) { int orow = crow(r, hi);
    for (int d0 = 0; d0 < 4; ++d0) Ow[(long)orow * LDO + d0 * 32 + r32] = __float2bfloat16(o[d0][r] * rli[r]); }
#undef SLOAD
#undef SWRITE
#undef SWAIT
#undef RESC
}

template <int D0> __device__ __forceinline__ void pv_ld(s16x4 (&t)[8], int vb) {
  t[0] = tr_read<v_rd_off(D0, 0, 0)>(vb); t[1] = tr_read<v_rd_off(D0, 0, 1)>(vb); t[2] = tr_read<v_rd_off(D0, 1, 0)>(vb); t[3] = tr_read<v_rd_off(D0, 1, 1)>(vb);
  t[4] = tr_read<v_rd_off(D0, 2, 0)>(vb); t[5] = tr_read<v_rd_off(D0, 2, 1)>(vb); t[6] = tr_read<v_rd_off(D0, 3, 0)>(vb); t[7] = tr_read<v_rd_off(D0, 3, 1)>(vb);
}
__device__ __forceinline__ void pv_mm(f32x16& od, const s16x4 (&t)[8], bf16x8 pa0, bf16x8 pa1, bf16x8 pa2, bf16x8 pa3) {
#define PK(L, H) (bf16x8){L[0], L[1], L[2], L[3], H[0], H[1], H[2], H[3]}
  od = __builtin_amdgcn_mfma_f32_32x32x16_bf16(pa0, PK(t[0], t[1]), od, 0, 0, 0);
  od = __builtin_amdgcn_mfma_f32_32x32x16_bf16(pa1, PK(t[2], t[3]), od, 0, 0, 0);
  od = __builtin_amdgcn_mfma_f32_32x32x16_bf16(pa2, PK(t[4], t[5]), od, 0, 0, 0);
  od = __builtin_amdgcn_mfma_f32_32x32x16_bf16(pa3, PK(t[6], t[7]), od, 0, 0, 0);
#undef PK
}
#define PV_WAIT8() do { asm volatile("s_waitcnt lgkmcnt(8)" ::: "memory"); SBAR(); } while (0)
__device__ __forceinline__ void pv8(f32x16* o, int vb, bf16x8 pa0, bf16x8 pa1, bf16x8 pa2, bf16x8 pa3) {
  s16x4 A[8], B[8]; const int vb2 = vb + 16384;
  pv_ld<0>(A, vb);
  pv_ld<1>(B, vb);  PV_WAIT8(); pv_mm(o[0], A, pa0, pa1, pa2, pa3);
  pv_ld<2>(A, vb);  PV_WAIT8(); pv_mm(o[1], B, pa0, pa1, pa2, pa3);
  pv_ld<3>(B, vb);  PV_WAIT8(); pv_mm(o[2], A, pa0, pa1, pa2, pa3);
  pv_ld<0>(A, vb2); PV_WAIT8(); pv_mm(o[3], B, pa0, pa1, pa2, pa3);
  pv_ld<1>(B, vb2); PV_WAIT8(); pv_mm(o[4], A, pa0, pa1, pa2, pa3);
  pv_ld<2>(A, vb2); PV_WAIT8(); pv_mm(o[5], B, pa0, pa1, pa2, pa3);
  pv_ld<3>(B, vb2); PV_WAIT8(); pv_mm(o[6], A, pa0, pa1, pa2, pa3);
  asm volatile("s_waitcnt lgkmcnt(0)" ::: "memory"); SBAR(); pv_mm(o[7], B, pa0, pa1, pa2, pa3);
}
#undef PV_WAIT8
constexpr int A256_V = 0, A256_K = 65536, A256_Q = 98304, A256_WS = 131072, A256_LDS = 133120;
__device__ __forceinline__ void attn256_body(const bf16* __restrict__ Qb, const bf16* __restrict__ Kh, const bf16* __restrict__ Vh, bf16* __restrict__ Ob, int seq, char* lds) {
  int tid_ = threadIdx.x; asm volatile("" : "+v"(tid_));
  const int tid = tid_, wid = __builtin_amdgcn_readfirstlane(tid >> 6), lane = tid & 63, r32 = lane & 31, hi = lane >> 5;
  typedef __attribute__((address_space(3))) unsigned lds_u32;
  char* Q_lds = lds + A256_Q + (wid * 4 * 64 + lane) * 16;
  float* ws = (float*)(lds + A256_WS) + wid * 64; float* li_l = ws; float* al_l = ws + 32;
  float m_reg = -1e30f, l_reg = 0; f32x16 o[8] = {}; bf16x8 qr[4];
  { const bf16* Qw = Qb + (long)(wid * QBLK + r32) * LDQ + hi * 8;
#pragma unroll
    for (int d0 = 0; d0 < 4; ++d0) qr[d0] = *reinterpret_cast<const bf16x8*>(Qw + d0 * 16);
#pragma unroll
    for (int d0 = 4; d0 < 8; ++d0) *(bf16x8*)(Q_lds + (d0 - 4) * 1024) = *reinterpret_cast<const bf16x8*>(Qw + d0 * 16); }
  int offk[2], offv[2];
#pragma unroll
  for (int i = 0; i < 2; ++i) { const int s = tid + 512 * i;
    { const int row = s >> 4, cs = s & 15; offk[i] = row * LDK + ((cs ^ (row & 7)) << 3); }
    { const int sub = s >> 5, rowk = (s >> 2) & 7, cc = s & 3, kk = (sub >> 2) * 8 + rowk, key = (kk & ~0xC) | ((kk & 4) << 1) | ((kk & 8) >> 1);
      offv[i] = key * LDK + (sub & 3) * 32 + cc * 8; } }
  const int ldsw = wid * 1024;
#define A256_DMA(k0, buf) do { const bf16* kt = Kh + (long)(k0) * LDK; const bf16* vt = Vh + (long)(k0) * LDK; \
    _Pragma("unroll") for (int i = 0; i < 2; ++i) { \
      __builtin_amdgcn_global_load_lds((const unsigned*)(kt + offk[i]), (lds_u32*)(lds + A256_K + (buf) * 16384 + ldsw + i * 8192), 16, 0, 0); \
      __builtin_amdgcn_global_load_lds((const unsigned*)(vt + offv[i]), (lds_u32*)(lds + A256_V + (buf) * 32768 + ldsw + i * 8192), 16, 0, 0); \
      __builtin_amdgcn_global_load_lds((const unsigned*)(vt + 128 + offv[i]), (lds_u32*)(lds + A256_V + (buf) * 32768 + 16384 + ldsw + i * 8192), 16, 0, 0); } } while (0)
#define A256_RESC(a) do { if (__any((a) < 1.f)) { if (hi == 0) al_l[r32] = (a); asm volatile("s_waitcnt lgkmcnt(0)" ::: "memory"); \
    for (int d = 0; d < 8; ++d) for (int r = 0; r < 16; ++r) o[d][r] *= al_l[crow(r, hi)]; } } while (0)
  const int vb0 = (int)(uintptr_t)(lds + A256_V) + v_rd_base(lane);
  f32x16 p0, p1; float mn, al; bf16x8 pa0, pa1, pa2, pa3; const int NT = seq / KVBLK;
  A256_DMA(0, 0);
  asm volatile("s_waitcnt vmcnt(0) lgkmcnt(0)" ::: "memory"); __builtin_amdgcn_s_barrier(); asm volatile("" ::: "memory");
  if (wid >= 4) __builtin_amdgcn_s_setprio(1);
  for (int j = 0; j < NT; ++j) {
    if (j + 1 < NT) A256_DMA((j + 1) * KVBLK, (j + 1) & 1);
    SBAR();
    const char* K_lds = lds + A256_K + (j & 1) * 16384;
    p0 = f32x16{}; p1 = f32x16{};
#pragma unroll
    for (int d0 = 0; d0 < 8; ++d0) { const int cb = (d0 * 16 + hi * 8) * 2;
      const bf16x8 b0 = *reinterpret_cast<const bf16x8*>(K_lds + KSWZ(r32, cb)), b1 = *reinterpret_cast<const bf16x8*>(K_lds + KSWZ(32 + r32, cb));
      const bf16x8 q = d0 < 4 ? qr[d0 & 3] : *reinterpret_cast<const bf16x8*>(Q_lds + (d0 - 4) * 1024);
      p0 = __builtin_amdgcn_mfma_f32_32x32x16_bf16(b0, q, p0, 0, 0, 0); p1 = __builtin_amdgcn_mfma_f32_32x32x16_bf16(b1, q, p1, 0, 0, 0); }
    SBAR();
    partialSM(p0, p1, m_reg, mn, al);
    A256_RESC(al);
    finishSM(p0, p1, al, l_reg, pa0, pa1, pa2, pa3); SBAR();
    pv8(o, vb0 + (j & 1) * 32768, pa0, pa1, pa2, pa3);
    asm volatile("s_waitcnt vmcnt(0) lgkmcnt(0)" ::: "memory"); __builtin_amdgcn_s_barrier(); asm volatile("" ::: "memory");
  }
  __builtin_amdgcn_s_setprio(0);
  if (hi == 0) li_l[r32] = l_reg; asm volatile("s_waitcnt lgkmcnt(0)" ::: "memory");
  float rli[16];
#pragma unroll
  for (int r = 0; r < 16; ++r) rli[r] = __builtin_amdgcn_rcpf(li_l[crow(r, hi)]);
  bf16* Ow = Ob + (long)(wid * QBLK) * LDO;
#pragma unroll
  for (int r = 0; r < 16; ++r) { const int orow = crow(r, hi);
#pragma unroll
    for (int d0 = 0; d0 < 8; ++d0) Ow[(long)orow * LDO + d0 * 32 + r32] = __float2bfloat16(o[d0][r] * rli[r]); }
#undef A256_DMA
#undef A256_RESC
}
}
#ifndef MK_PER_PHASE
#define MK_PER_PHASE 0
#endif
constexpr int NWAVES = 8;
constexpr int M = 8192, SEQ = 4096, DM = 4096, FF = 3072, NP = 26624, NL = 4;
constexpr float EPS = 1e-6f;
constexpr int P_AQ = 0, P_AK = 2048, P_AV = 4096, P_GQ = 6144, P_GK = 6656, P_GV = 7168, P_GR = 8192, P_HQ = 9216, P_HZF = 10240, P_HZB = 11264, P_HI = 12288, P_HG = 13312,
              P_GA = 14336, P_GG = 18432, P_GH = 22528;
constexpr size_t MiB = 1u << 20;
constexpr size_t WS_CTL = 0, CTL_ZERO_BYTES = 2 * MiB;
constexpr size_t WS_TAB = 2 * MiB;
constexpr size_t WS_ROPE = 3 * MiB;
constexpr size_t WS_W = 5 * MiB;
constexpr size_t OW_1A = 0, OW_1B = OW_1A + (size_t)6144 * 4096, OW_IN = OW_1B + (size_t)4096 * 3072, OW_A = OW_IN + (size_t)NP * 4096, OW_B = OW_A + (size_t)4096 * 2048,
                 OW_C = OW_B + (size_t)4096 * 1024, OW_O = OW_C + (size_t)4096 * 1024, OW_2A = OW_O + (size_t)4096 * 4096, OW_2B = OW_2A + (size_t)6144 * 4096, LAYER_W = OW_2B + (size_t)4096 * 3072;
constexpr size_t WS_H = WS_W + ((NL * LAYER_W * 2 + MiB - 1) / MiB) * MiB;
constexpr size_t WS_ACT = WS_H + (size_t)M * DM * 2;
constexpr size_t WS_P = WS_ACT + (size_t)M * FF * 2;
constexpr size_t WS_QN = WS_P + (size_t)M * NP * 2;
constexpr size_t WS_KN = WS_QN + (size_t)M * 2048 * 2;
constexpr size_t WS_VN = WS_KN + (size_t)M * 2048 * 2;
constexpr size_t WS_GF = WS_VN + (size_t)M * 2048 * 2;
constexpr size_t WS_HF = WS_GF + (size_t)2 * M * 512 * 4;
constexpr size_t WS_O12 = WS_HF + (size_t)2 * M * 1024 * 4;
constexpr size_t WS_OSG = WS_O12 + (size_t)2 * M * 2048 * 4;
constexpr size_t WS_OSH = WS_OSG + (size_t)2 * M * 1024 * 4;
constexpr size_t WS_OA = WS_OSH + (size_t)2 * M * 1024 * 4;
constexpr size_t WS_OG = WS_OA + (size_t)M * 2048 * 2;
constexpr size_t WS_OH = WS_OG + (size_t)M * 1024 * 2;
constexpr size_t WS_M32 = WS_OH + (size_t)M * 1024 * 2;
constexpr size_t WS_MB = WS_M32 + (size_t)M * DM * 4;
constexpr size_t WS_WLR = WS_MB + (size_t)M * DM * 2;
constexpr size_t WS_END = WS_WLR + (size_t)NL * 32 * 4096 * 2;
constexpr size_t WS_X8 = WS_M32;
constexpr int G8_D0 = P_GA / 32;
constexpr size_t OW8_OFF = (size_t)P_GA * 4096;
constexpr int CW_TMO = 0, CW_BAR = 4096;
constexpr size_t WS_SS = 1 * MiB;
static_assert(WS_SS + (size_t)(1 + 3 * NL) * M * 8 <= CTL_ZERO_BYTES, "SS inside the memset region");
constexpr int RING_OFF = 0, RING_BYTES = 151552;
constexpr int LDSCTL_OFF = RING_BYTES, MISC_OFF = LDSCTL_OFF + 320;
constexpr int LDS_BYTES = 163840;
static_assert(att::A256_LDS <= RING_BYTES && MISC_OFF + 128 <= LDS_BYTES, "LDS map");

#define GAS __attribute__((address_space(1)))
#define LAS __attribute__((address_space(3)))
typedef unsigned short bf16;
typedef unsigned v4u __attribute__((ext_vector_type(4)));
typedef unsigned v2u __attribute__((ext_vector_type(2)));
typedef float f32x4 __attribute__((ext_vector_type(4)));
typedef float f32x2 __attribute__((ext_vector_type(2)));
typedef GAS unsigned gu32;
#define RLX_AGENT __ATOMIC_RELAXED, __HIP_MEMORY_SCOPE_AGENT
#define LDS_WAIT() asm volatile("s_waitcnt lgkmcnt(0)" ::: "memory")
#define VM_WAIT() asm volatile("s_waitcnt vmcnt(0)" ::: "memory")
typedef __bf16 bf16x2_t __attribute__((ext_vector_type(2)));
__device__ __forceinline__ unsigned pk2(float lo, float hi) { const f32x2 v = {lo, hi}; return __builtin_bit_cast(unsigned, __builtin_convertvector(v, bf16x2_t)); }
__device__ __forceinline__ float bflo(unsigned w) { return __uint_as_float(w << 16); }
__device__ __forceinline__ float bfhi(unsigned w) { return __uint_as_float(w & 0xffff0000u); }
__device__ __forceinline__ float bf1(bf16 h) { return __uint_as_float(((unsigned)h) << 16); }
__device__ __forceinline__ float sigm(float x) { return __builtin_amdgcn_rcpf(1.0f + __builtin_amdgcn_exp2f(-1.4426950408889634f * x)); }

#define XB_TMO      128
#define XB_XCNT(j)  (256  + 64 * (j))
#define XB_XSUB(j)  (1280 + 64 * (j))
#define XB_XGEN(j)  (2304 + 64 * (j))
#define XB_TOP      3328
#define XB_TOPGEN   3392
#define XCD_BAR_WORDS 3456
#define XB_SPIN_CAP (1u << 18)

__device__ __forceinline__ unsigned xb_ld(unsigned* p)              { return __hip_atomic_load(p, __ATOMIC_RELAXED, __HIP_MEMORY_SCOPE_AGENT); }
__device__ __forceinline__ unsigned xb_add(unsigned* p, unsigned v) { return __hip_atomic_fetch_add(p, v, __ATOMIC_RELAXED, __HIP_MEMORY_SCOPE_AGENT); }
__device__ __forceinline__ unsigned xb_xcc_id() { return (unsigned)__builtin_amdgcn_s_getreg((3 << 11) | 20) & 0xFu; }
#define XB_SPIN(cond, bar) do { unsigned _sp = 0; while (cond) { __builtin_amdgcn_s_sleep(1); \
    if ((++_sp & 255u) == 0u) { if (xb_ld(&(bar)[XB_TMO])) break; if (_sp > XB_SPIN_CAP) { atomicAdd(&(bar)[XB_TMO], 1u); break; } } } } while (0)

struct XcdBarrier {
    unsigned* bar; unsigned x;
    volatile LAS unsigned* st;
};

__device__ __forceinline__ XcdBarrier xcd_barrier_post(unsigned* bar, volatile LAS unsigned* st) {
    XcdBarrier b; b.bar = bar; b.x = xb_xcc_id(); b.st = st;
    if (threadIdx.x == 0) (void)xb_add(&bar[XB_XCNT(b.x)], 1u);
    return b;
}
__device__ __forceinline__ void xcd_barrier_complete(unsigned* bar, unsigned x, unsigned& nloc, unsigned& nx) {
    const unsigned G = gridDim.x * gridDim.y * gridDim.z;
    unsigned sum, cnt, mine, sp = 0u;
    for (;;) {
        sum = 0u; cnt = 0u; mine = 0u;
#pragma unroll
        for (unsigned j = 0; j < 16; ++j) { const unsigned c = xb_ld(&bar[XB_XCNT(j)]); sum += c; cnt += (c > 0u) ? 1u : 0u; mine = (j == x) ? c : mine; }
        if (sum == G) break;
        __builtin_amdgcn_s_sleep(1);
        if ((++sp & 255u) == 0u) { if (xb_ld(&bar[XB_TMO])) break; if (sp > XB_SPIN_CAP) { atomicAdd(&bar[XB_TMO], 1u); break; } }
    }
    nloc = mine > 0u ? mine : 1u; nx = cnt > 0u ? cnt : 1u;
}

__device__ __forceinline__ void xcd_barrier(const XcdBarrier& b) {
    asm volatile("s_waitcnt vmcnt(0)" ::: "memory");
    __syncthreads();
    if (threadIdx.x == 0) {
        unsigned* bar = b.bar;
        __builtin_amdgcn_s_waitcnt(0);
        unsigned nloc = b.st[0], nx = b.st[1];
        if (nloc == 0u) { xcd_barrier_complete(bar, b.x, nloc, nx); b.st[0] = nloc; b.st[1] = nx; }
        const unsigned old = xb_add(&bar[XB_XSUB(b.x)], 1u);
        const unsigned gen = old / nloc;
        if (old + 1u == (gen + 1u) * nloc) {
            __builtin_amdgcn_fence(__ATOMIC_RELEASE, "agent");
            asm volatile("s_waitcnt vmcnt(0)" ::: "memory");
            const unsigned og = xb_add(&bar[XB_TOP], 1u);
            const unsigned tg = og / nx;
            if (og + 1u == (tg + 1u) * nx) xb_add(&bar[XB_TOPGEN], 1u);
            else XB_SPIN(xb_ld(&bar[XB_TOPGEN]) == tg, bar);
            __builtin_amdgcn_fence(__ATOMIC_ACQUIRE, "agent");
            xb_add(&bar[XB_XGEN(b.x)], 1u);
            asm volatile("s_waitcnt vmcnt(0)" ::: "memory");
        } else {
            XB_SPIN(xb_ld(&bar[XB_XGEN(b.x)]) == gen, bar);
            __builtin_amdgcn_fence(__ATOMIC_ACQUIRE, "agent");
            asm volatile("s_waitcnt vmcnt(0)" ::: "memory");
        }
    }
    __syncthreads();
}

struct Ctx {
    LAS unsigned char* lds;
    int wave, G, vcu, gw, ngw;
    const float* const* in; float* out; unsigned char* ws;
};
__device__ __forceinline__ int opaque_tid() { int t = threadIdx.x; asm volatile("" : "+v"(t)); return t; }
__device__ __forceinline__ int opaque_gw(const Ctx& C) { int g = C.gw; asm volatile("" : "+s"(g)); return g; }
__device__ __forceinline__ unsigned char* opaque_ws(const Ctx& C) { unsigned z = 0u; asm volatile("" : "+s"(z)); return C.ws + z; }
__device__ __forceinline__ float wave_sum(float v) {
#pragma unroll
    for (int o = 1; o < 64; o <<= 1) v += __shfl_xor(v, o);
    return v;
}
__device__ __forceinline__ float half_sum32(float v) {
#pragma unroll
    for (int o = 1; o < 32; o <<= 1) v += __shfl_xor(v, o);
    return v;
}

constexpr float W8_SCALE = 256.0f;
template <bool F8 = false> __device__ __forceinline__ void tr_item(const float* W, int ldw, int srccol, bf16* WT, int K, int dstrow, int kb, LAS float* scr, int lane, const float* gain = nullptr, int kdst = 0) {
    const int k0 = 64 * kb;
    if (srccol < 0) {
        const int n = lane & 31, cp = lane >> 5;
#pragma unroll
        for (int j = 0; j < 4; ++j) *(GAS v4u*)(WT + (size_t)(dstrow + n) * K + kdst + k0 + 8 * (cp + 2 * j)) = (v4u){0u, 0u, 0u, 0u};
        return;
    }
    const int rr = lane >> 3, cq = lane & 7;
    f32x4 v[8];
    const float* src = W + (size_t)(k0 + rr) * ldw + srccol + 4 * cq;
#pragma unroll
    for (int i = 0; i < 8; ++i) v[i] = __builtin_nontemporal_load((const GAS f32x4*)(src + (size_t)(8 * i) * ldw));
    if (gain) {
#pragma unroll
        for (int i = 0; i < 8; ++i) v[i] = v[i] * gain[k0 + 8 * i + rr];
    }
#pragma unroll
    for (int i = 0; i < 8; ++i) {
#pragma unroll
        for (int e = 0; e < 4; ++e) scr[(4 * cq + e) * 65 + 8 * i + rr] = v[i][e];
    }
    LDS_WAIT(); asm volatile("" ::: "memory");
    const int n = lane & 31, cp = lane >> 5;
#pragma unroll
    for (int j = 0; j < 4; ++j) { const int c = cp + 2 * j; const LAS float* s = scr + n * 65 + 8 * c;
        if (F8) { int lo = __builtin_amdgcn_cvt_pk_fp8_f32(s[0] * W8_SCALE, s[1] * W8_SCALE, 0, false); lo = __builtin_amdgcn_cvt_pk_fp8_f32(s[2] * W8_SCALE, s[3] * W8_SCALE, lo, true);
            int hi = __builtin_amdgcn_cvt_pk_fp8_f32(s[4] * W8_SCALE, s[5] * W8_SCALE, 0, false); hi = __builtin_amdgcn_cvt_pk_fp8_f32(s[6] * W8_SCALE, s[7] * W8_SCALE, hi, true);
            *(GAS v2u*)((unsigned char*)WT + (size_t)(dstrow + n) * K + kdst + k0 + 8 * c) = (v2u){(unsigned)lo, (unsigned)hi}; }
        else { v4u o; o.x = pk2(s[0], s[1]); o.y = pk2(s[2], s[3]); o.z = pk2(s[4], s[5]); o.w = pk2(s[6], s[7]);
            *(GAS v4u*)(WT + (size_t)(dstrow + n) * K + kdst + k0 + 8 * c) = o; } }
    LDS_WAIT(); asm volatile("" ::: "memory");
}
constexpr int I_1A = 64 * 192, I_1B = 48 * 128, I_IN = 64 * 832, I_LR = 64, I_A = 32 * 128, I_B = 16 * 128, I_C = 16 * 128, I_O = 64 * 128;
constexpr int I_LAYER = I_1A + I_1B + I_IN + I_LR + I_A + I_B + I_C + I_O + I_1A + I_1B, I_EARLY = I_1A + I_1B + I_IN + I_LR, I_LATE = I_LAYER - I_EARLY;
__device__ __forceinline__ void conv_item(Ctx& C, unsigned char* ws, int l, int r, LAS float* scr, int lane) {
    bf16* wl = (bf16*)(ws + WS_W) + (size_t)l * LAYER_W;
        if (r < I_1A) { const float* W = C.in[2] + (size_t)l * 4096 * 6144; const int kb = r / 192, d = r % 192, pn = d >> 3, bj = (d >> 2) & 1, q = d & 3;
            tr_item(W, 6144, bj * 3072 + pn * 128 + q * 32, wl + OW_1A, 4096, d * 32, kb, scr, lane, C.in[1] + l * DM); return; }
        r -= I_1A;
        if (r < I_1B) { const float* W = C.in[3] + (size_t)l * 3072 * 4096; const int kb = r / 128, d = r % 128;
            tr_item(W, 4096, d * 32, wl + OW_1B, 3072, d * 32, kb, scr, lane); return; }
        r -= I_1B;
        if (r < I_IN) { const float* W = C.in[5] + (size_t)l * 4096 * 26656; const int kb = r / 832, d = r % 832;
            if (d < G8_D0) tr_item(W, 26656, (d < 288 ? d : d + 1) * 32, wl + OW_IN, 4096, d * 32, kb, scr, lane, C.in[4] + l * DM);
            else tr_item<true>(W, 26656, (d + 1) * 32, wl + OW_IN + OW8_OFF, 4096, (d - G8_D0) * 32, kb, scr, lane, C.in[4] + l * DM);
            return; }
        r -= I_IN;
        if (r < I_LR) { const float* W = C.in[5] + (size_t)l * 4096 * 26656;
            tr_item(W, 26656, 9216, (bf16*)(ws + WS_WLR) + (size_t)l * 32 * 4096, 4096, 0, r, scr, lane, C.in[4] + l * DM); return; }
        r -= I_LR;
        if (r < I_A) { const float* W = C.in[18] + (size_t)l * 2048 * 4096; const int kb = r / 128, d = r % 128;
            tr_item(W, 4096, d * 32, wl + OW_A, 4096, d * 32, kb, scr, lane, nullptr, 0); return; }
        r -= I_A;
        if (r < I_B) { const float* W = C.in[19] + (size_t)l * 1024 * 4096; const int kb = r / 128, d = r % 128;
            tr_item(W, 4096, d * 32, wl + OW_A, 4096, d * 32, kb, scr, lane, nullptr, 2048); return; }
        r -= I_B;
        if (r < I_C) { const float* W = C.in[20] + (size_t)l * 1024 * 4096; const int kb = r / 128, d = r % 128;
            tr_item(W, 4096, d * 32, wl + OW_A, 4096, d * 32, kb, scr, lane, nullptr, 3072); return; }
        r -= I_C;
        if (r < I_O) { const float* W = C.in[21] + (size_t)l * 4096 * 4096; const int kb = r / 128, d = r % 128;
            tr_item(W, 4096, d * 32, wl + OW_O, 4096, d * 32, kb, scr, lane); return; }
        r -= I_O;
        if (r < I_1A) { const float* W = C.in[23] + (size_t)l * 4096 * 6144; const int kb = r / 192, d = r % 192, pn = d >> 3, bj = (d >> 2) & 1, q = d & 3;
            tr_item(W, 6144, bj * 3072 + pn * 128 + q * 32, wl + OW_2A, 4096, d * 32, kb, scr, lane, C.in[22] + l * DM); return; }
        r -= I_1A;
        { const float* W = C.in[24] + (size_t)l * 3072 * 4096; const int kb = r / 128, d = r % 128;
            tr_item(W, 4096, d * 32, wl + OW_2B, 3072, d * 32, kb, scr, lane); }
}
__device__ __forceinline__ void prologue(Ctx& C) {
    const int lane = opaque_tid() & 63; unsigned char* ws = opaque_ws(C);
    LAS float* scr = (LAS float*)(C.lds + RING_OFF + C.wave * 8448);
    for (int it = C.gw; it < I_EARLY; it += C.ngw) conv_item(C, ws, 0, it, scr, lane);
    { bf16* XB = (bf16*)(ws + WS_H); unsigned long long* SS0 = (unsigned long long*)(ws + WS_SS); const float* x = C.in[0];
      for (int m = C.gw; m < M; m += C.ngw) { const GAS f32x4* xr = (const GAS f32x4*)(x + (size_t)m * DM) + lane; GAS v2u* o = (GAS v2u*)(XB + (size_t)m * DM) + lane; float q = 0.f;
#pragma unroll
        for (int j = 0; j < 16; ++j) { const f32x4 v = xr[64 * j]; q += (v.x * v.x + v.y * v.y) + (v.z * v.z + v.w * v.w); o[64 * j] = (v2u){pk2(v.x, v.y), pk2(v.z, v.w)}; }
        q = wave_sum(q); if (lane == 0) SS0[m] = (unsigned long long)(q * 1048576.0f + 0.5f); } }
    f32x2* rope = (f32x2*)(ws + WS_ROPE);
    for (int e = C.gw * 64 + lane; e < SEQ * 64; e += C.ngw * 64) {
        const int pos = e >> 6, i = e & 63;
        const float inv = powf(10000.0f, -(float)i * (1.0f / 64.0f));
        const float ang = (float)pos * inv;
        float s, c; sincosf(ang, &s, &c);
        rope[e] = (f32x2){c, s};
    }
    float* LB = (float*)(ws + WS_TAB);
    for (int e = C.gw * 64 + lane; e < 2 * 1024; e += C.ngw * 64) {
        const int dir = e >> 10, c = e & 1023; const float* lg = dir ? C.in[16] : C.in[15];
        float z[NL], mx = -1e30f;
#pragma unroll
        for (int l = 0; l < NL; ++l) { z[l] = lg[l * 1024 + c]; mx = fmaxf(mx, z[l]); }
        float sum = 0.f;
#pragma unroll
        for (int l = 0; l < NL; ++l) { z[l] = expf(z[l] - mx); sum += z[l]; }
        const float p0 = z[0] / sum; float cum = 0.f;
#pragma unroll
        for (int l = 0; l < NL; ++l) { cum += z[l] / sum; const float lb = fminf(fmaxf(cum - p0, 0.0f), 1.0f - 1e-6f); LB[(dir * NL + l) * 1024 + c] = lb; }
    }
    if (C.gw < NL) {
        const int l = C.gw; const float* lv = C.in[8] + (size_t)l * 4 * 128;
        float a = lv[lane] * lv[128 + lane] + lv[64 + lane] * lv[128 + 64 + lane];
        float b = lv[256 + lane] * lv[384 + lane] + lv[256 + 64 + lane] * lv[384 + 64 + lane];
        a = wave_sum(a); b = wave_sum(b);
        const float lam_init = 0.8f - 0.6f * expf(-0.3f * (float)l);
        if (lane == 0) { float* LAM = (float*)(ws + WS_TAB + 65536); LAM[2 * l] = expf(a) - expf(b) + lam_init; LAM[2 * l + 1] = 1.0f - lam_init; }
    }
}

typedef short sbf16x8 __attribute__((ext_vector_type(8)));
#define MFMA16(Pf, Qf, ACC) __builtin_amdgcn_mfma_f32_16x16x32_bf16((Pf), (Qf), (ACC), 0, 0, 0)
__device__ __forceinline__ float row16_sum(float v) {
#pragma unroll
    for (int o = 1; o < 16; o <<= 1) v += __shfl_xor(v, o);
    return v;
}
__device__ __forceinline__ void prep_phase(Ctx& C, int l) {
    const int tid = opaque_tid(), lane = tid & 63; unsigned char* ws = opaque_ws(C);
    const bf16* P = (const bf16*)(ws + WS_P);
    bf16* QN = (bf16*)(ws + WS_QN); bf16* KN = (bf16*)(ws + WS_KN);
    float* GF = (float*)(ws + WS_GF); float* HF = (float*)(ws + WS_HF);
    const float* LB = (const float*)(ws + WS_TAB);
    const f32x4* rope = (const f32x4*)(ws + WS_ROPE);
    const int g4 = lane >> 4, j = lane & 15;
    LAS float* LW = (LAS float*)(C.lds + RING_OFF);
    { const float* w2f = C.in[10] + (size_t)l * 16 * 512; const float* w2b = C.in[12] + (size_t)l * 16 * 512; const float* bf_ = C.in[11] + (size_t)l * 512; const float* bb_ = C.in[13] + (size_t)l * 512;
      for (int i = tid; i < 2048; i += NWAVES * 64) { *(LAS f32x4*)(LW + 4 * i) = *(const GAS f32x4*)(w2f + 4 * i); *(LAS f32x4*)(LW + 8192 + 4 * i) = *(const GAS f32x4*)(w2b + 4 * i); }
      if (tid < 128) *(LAS f32x4*)(LW + 16384 + 4 * tid) = *(const GAS f32x4*)(bf_ + 4 * tid); else if (tid < 256) *(LAS f32x4*)(LW + 16384 + 512 + 4 * (tid - 128)) = *(const GAS f32x4*)(bb_ + 4 * (tid - 128));
      LDS_WAIT(); __syncthreads(); }
    const float* qg = C.in[6] + l * 128; const float* kg = C.in[7] + l * 128;
    const f32x4 gq0 = *(const GAS f32x4*)(qg + 4 * j), gq1 = *(const GAS f32x4*)(qg + 64 + 4 * j), gk0 = *(const GAS f32x4*)(kg + 4 * j), gk1 = *(const GAS f32x4*)(kg + 64 + 4 * j);
    const bf16* XB = (const bf16*)(ws + WS_H); const bf16* WLR = (const bf16*)(ws + WS_WLR) + (size_t)l * 32 * 4096;
    const unsigned long long* SSm = (const unsigned long long*)(ws + WS_SS) + (size_t)(3 * l + 1) * M;
    LAS float* PB = (LAS float*)(C.lds + RING_OFF + 72 * 1024);
    LAS float* LR = (LAS float*)(C.lds + RING_OFF + 104 * 1024);
    for (int tb = C.vcu; tb < M / 32; tb += C.G) {
    {
        const int r = lane & 15, g = lane >> 4;
        f32x4 acc00 = {0.f, 0.f, 0.f, 0.f}, acc01 = acc00, acc10 = acc00, acc11 = acc00;
        const bf16* xa = XB + (size_t)(32 * tb + r) * DM + 512 * C.wave + 8 * g; const bf16* wb = WLR + (size_t)r * 4096 + 512 * C.wave + 8 * g;
#pragma unroll 4
        for (int ks = 0; ks < 16; ++ks) {
            const sbf16x8 a0 = *(const GAS sbf16x8*)(xa + 32 * ks), a1 = *(const GAS sbf16x8*)(xa + 16 * DM + 32 * ks);
            const sbf16x8 b0 = *(const GAS sbf16x8*)(wb + 32 * ks), b1 = *(const GAS sbf16x8*)(wb + 16 * 4096 + 32 * ks);
            acc00 = MFMA16(a0, b0, acc00); acc01 = MFMA16(a0, b1, acc01); acc10 = MFMA16(a1, b0, acc10); acc11 = MFMA16(a1, b1, acc11);
        }
        LAS float* pw = PB + C.wave * 1024;
#pragma unroll
        for (int e = 0; e < 4; ++e) { pw[(4 * g + e) * 32 + r] = acc00[e]; pw[(4 * g + e) * 32 + 16 + r] = acc01[e]; pw[(16 + 4 * g + e) * 32 + r] = acc10[e]; pw[(16 + 4 * g + e) * 32 + 16 + r] = acc11[e]; }
        LDS_WAIT(); __syncthreads();
#pragma unroll
        for (int q = 0; q < 2; ++q) { const int idx = tid + 512 * q; float sum = 0.f;
#pragma unroll
            for (int w8 = 0; w8 < 8; ++w8) sum += PB[w8 * 1024 + idx];
            const int tk = idx >> 5; LR[idx] = sum * __builtin_amdgcn_rsqf((float)SSm[32 * tb + tk] * (1.0f / 1048576.0f) * (1.0f / DM) + EPS); }
        LDS_WAIT(); __syncthreads();
    }
    for (int tk4 = 0; tk4 < 4; ++tk4) {
        const int tl = 4 * C.wave + tk4, m = 32 * tb + tl;
        const bf16* prow = P + (size_t)m * NP; const int pos = m & (SEQ - 1);
        const f32x4 cs0 = rope[pos * 32 + 2 * j], cs1 = rope[pos * 32 + 2 * j + 1];
        v2u lo[8], hi[8];
#pragma unroll
        for (int it = 0; it < 8; ++it) { const int g = 4 * it + g4; lo[it] = *(const GAS v2u*)(prow + g * 128 + 4 * j); hi[it] = *(const GAS v2u*)(prow + g * 128 + 64 + 4 * j); }
#pragma unroll
        for (int it = 0; it < 8; ++it) {
            const int g = 4 * it + g4;
            f32x4 x = {bflo(lo[it].x), bfhi(lo[it].x), bflo(lo[it].y), bfhi(lo[it].y)}, y = {bflo(hi[it].x), bfhi(hi[it].x), bflo(hi[it].y), bfhi(hi[it].y)};
            const float ss = row16_sum(((x[0] * x[0] + x[1] * x[1]) + (x[2] * x[2] + x[3] * x[3])) + ((y[0] * y[0] + y[1] * y[1]) + (y[2] * y[2] + y[3] * y[3])));
            const float rstd = __builtin_amdgcn_rsqf(ss * (1.0f / 128.0f) + EPS);
            const bool isq = it < 4;
            x = x * rstd * (isq ? gq0 : gk0); y = y * rstd * (isq ? gq1 : gk1);
            const float ox0 = x[0] * cs0.x - y[0] * cs0.y, oy0 = y[0] * cs0.x + x[0] * cs0.y, ox1 = x[1] * cs0.z - y[1] * cs0.w, oy1 = y[1] * cs0.z + x[1] * cs0.w;
            const float ox2 = x[2] * cs1.x - y[2] * cs1.y, oy2 = y[2] * cs1.x + x[2] * cs1.y, ox3 = x[3] * cs1.z - y[3] * cs1.w, oy3 = y[3] * cs1.z + x[3] * cs1.w;
            bf16* dst = (isq ? QN + (size_t)m * 2048 + g * 128 : KN + (size_t)m * 2048 + (g - 16) * 128);
            *(GAS v2u*)(dst + 4 * j) = (v2u){pk2(ox0, ox1), pk2(ox2, ox3)}; *(GAS v2u*)(dst + 64 + 4 * j) = (v2u){pk2(oy0, oy1), pk2(oy2, oy3)};
        }
        float lr[32];
#pragma unroll
        for (int i = 0; i < 8; ++i) { const f32x4 t4 = *(const LAS f32x4*)(LR + tl * 32 + 4 * i); lr[4 * i] = t4[0]; lr[4 * i + 1] = t4[1]; lr[4 * i + 2] = t4[2]; lr[4 * i + 3] = t4[3]; }
#pragma unroll
        for (int dir = 0; dir < 2; ++dir) {
#pragma unroll
            for (int jj = 0; jj < 2; ++jj) { const int c = 4 * lane + 256 * jj; f32x4 z = *(const LAS f32x4*)(LW + 16384 + 512 * dir + c);
#pragma unroll
                for (int r = 0; r < 16; ++r) z = z + *(const LAS f32x4*)(LW + 8192 * dir + r * 512 + c) * lr[16 * dir + r];
                f32x4 o;
#pragma unroll
                for (int e = 0; e < 4; ++e) o[e] = (fminf(z[e], 0.0f) - __logf(1.0f + __expf(-fabsf(z[e])))) * (1.0f / 16.0f);
                *(GAS f32x4*)(GF + ((size_t)dir * M + m) * 512 + c) = o; asm volatile("" ::: "memory"); }
        }
#pragma unroll
        for (int dir = 0; dir < 2; ++dir) {
#pragma unroll
            for (int jj = 0; jj < 4; ++jj) { const int c = 4 * lane + 256 * jj; const v2u zw = *(const GAS v2u*)(prow + (dir ? P_HZB : P_HZF) + c);
                const f32x4 lb = *(const GAS f32x4*)(LB + (dir * NL + l) * 1024 + c); const f32x4 z = {bflo(zw.x), bfhi(zw.x), bflo(zw.y), bfhi(zw.y)};
                f32x4 o;
#pragma unroll
                for (int e = 0; e < 4; ++e) o[e] = __logf(fmaxf(lb[e], 1e-20f) + (1.0f - lb[e]) * sigm(z[e]));
                *(GAS f32x4*)(HF + ((size_t)dir * M + m) * 1024 + c) = o; }
        }
    }
    __syncthreads();
    }
}

__device__ __forceinline__ f32x4 ld4bf(const bf16* p) { const v2u w = *(const GAS v2u*)p; return (f32x4){bflo(w.x), bfhi(w.x), bflo(w.y), bfhi(w.y)}; }
__device__ __forceinline__ void post_phase(Ctx& C, int l) {
    const int lane = opaque_tid() & 63; unsigned char* ws = opaque_ws(C);
    const bf16* P = (const bf16*)(ws + WS_P);
    const bf16* O1 = (const bf16*)(ws + WS_O12); const bf16* O2 = O1 + (size_t)M * 2048;
    const bf16* SG0 = (const bf16*)(ws + WS_OSG); const bf16* SG1 = SG0 + (size_t)M * 1024;
    const bf16* SH0 = (const bf16*)(ws + WS_OSH); const bf16* SH1 = SH0 + (size_t)M * 1024;
    bf16* OC = (bf16*)(ws + WS_OA);
    const float* LAM = (const float*)(ws + WS_TAB + 65536);
    const float lam = LAM[2 * l], oml = LAM[2 * l + 1];
    const int g4 = lane >> 4, j = lane & 15;
    f32x4 ga[4], gg[4], gh[2];
#pragma unroll
    for (int i = 0; i < 4; ++i) { ga[i] = *(const GAS f32x4*)(C.in[9] + l * 256 + 64 * i + 4 * j); gg[i] = *(const GAS f32x4*)(C.in[14] + l * 256 + 64 * i + 4 * j); }
#pragma unroll
    for (int i = 0; i < 2; ++i) gh[i] = *(const GAS f32x4*)(C.in[17] + l * 128 + 64 * i + 4 * j);
    for (int m = opaque_gw(C); m < M; m += C.ngw) {
        const bf16* prow = P + (size_t)m * NP;
        f32x4 da[2][4];
#pragma unroll
        for (int it = 0; it < 2; ++it)
#pragma unroll
            for (int i = 0; i < 4; ++i) { const size_t o = (size_t)m * 2048 + (4 * it + g4) * 256 + 64 * i + 4 * j; da[it][i] = ld4bf(O1 + o) - ld4bf(O2 + o) * lam; }
        f32x4 dg[4]; v2u rg[4];
#pragma unroll
        for (int i = 0; i < 4; ++i) { const size_t o = (size_t)m * 1024 + g4 * 256 + 64 * i + 4 * j; dg[i] = ld4bf(SG0 + o) + ld4bf(SG1 + o); rg[i] = *(const GAS v2u*)(prow + P_GR + g4 * 256 + 64 * i + 4 * j); }
        f32x4 dh[2][2]; v2u rh[2][2];
#pragma unroll
        for (int it = 0; it < 2; ++it)
#pragma unroll
            for (int i = 0; i < 2; ++i) { const size_t o = (size_t)m * 1024 + (4 * it + g4) * 128 + 64 * i + 4 * j; dh[it][i] = ld4bf(SH0 + o) + ld4bf(SH1 + o);
                rh[it][i] = *(const GAS v2u*)(prow + P_HG + (4 * it + g4) * 128 + 64 * i + 4 * j); }
#pragma unroll
        for (int it = 0; it < 2; ++it) { float q = 0.f;
#pragma unroll
            for (int i = 0; i < 4; ++i) { const f32x4 d = da[it][i]; q += (d.x * d.x + d.y * d.y) + (d.z * d.z + d.w * d.w); }
            const float rstd = __builtin_amdgcn_rsqf(row16_sum(q) * (1.0f / 256.0f) + EPS) * oml;
#pragma unroll
            for (int i = 0; i < 4; ++i) { const f32x4 y = da[it][i] * rstd * ga[i]; *(GAS v2u*)(OC + (size_t)m * 4096 + (4 * it + g4) * 256 + 64 * i + 4 * j) = (v2u){pk2(y.x, y.y), pk2(y.z, y.w)}; } }
        { float q = 0.f;
#pragma unroll
            for (int i = 0; i < 4; ++i) { const f32x4 d = dg[i]; q += (d.x * d.x + d.y * d.y) + (d.z * d.z + d.w * d.w); }
            const float rstd = __builtin_amdgcn_rsqf(row16_sum(q) * (1.0f / 256.0f) + EPS);
#pragma unroll
            for (int i = 0; i < 4; ++i) { const f32x4 y = dg[i] * rstd * gg[i]; const float r0 = bflo(rg[i].x), r1 = bfhi(rg[i].x), r2 = bflo(rg[i].y), r3 = bfhi(rg[i].y);
                *(GAS v2u*)(OC + (size_t)m * 4096 + 2048 + g4 * 256 + 64 * i + 4 * j) = (v2u){pk2(y.x * r0 * sigm(r0), y.y * r1 * sigm(r1)), pk2(y.z * r2 * sigm(r2), y.w * r3 * sigm(r3))}; } }
#pragma unroll
        for (int it = 0; it < 2; ++it) { float q = 0.f;
#pragma unroll
            for (int i = 0; i < 2; ++i) { const f32x4 d = dh[it][i]; q += (d.x * d.x + d.y * d.y) + (d.z * d.z + d.w * d.w); }
            const float rstd = __builtin_amdgcn_rsqf(row16_sum(q) * (1.0f / 128.0f) + EPS);
#pragma unroll
            for (int i = 0; i < 2; ++i) { const f32x4 y = dh[it][i] * rstd * gh[i]; const float r0 = bflo(rh[it][i].x), r1 = bfhi(rh[it][i].x), r2 = bflo(rh[it][i].y), r3 = bfhi(rh[it][i].y);
                *(GAS v2u*)(OC + (size_t)m * 4096 + 3072 + (4 * it + g4) * 128 + 64 * i + 4 * j) = (v2u){pk2(y.x * r0 * sigm(r0), y.y * r1 * sigm(r1)), pk2(y.z * r2 * sigm(r2), y.w * r3 * sigm(r3))}; } }
    }
}

__device__ __forceinline__ sbf16x8 pack8(const f32x4 a, const f32x4 b) { v4u w = {pk2(a[0], a[1]), pk2(a[2], a[3]), pk2(b[0], b[1]), pk2(b[2], b[3])}; return __builtin_bit_cast(sbf16x8, w); }
__device__ __forceinline__ sbf16x8 cat64(const v2u lo, const v2u hi) { v4u w = {lo.x, lo.y, hi.x, hi.y}; return __builtin_bit_cast(sbf16x8, w); }
template <bool GLA>
__device__ __forceinline__ void scan_chain(Ctx& C, int b, int h, int dir) {
    constexpr int DV = GLA ? 256 : 128, NVJ = DV / 128, NVI = DV / 128;
    constexpr int CH = 32, NCH = SEQ / CH;
    constexpr int QI = 0, KI = 8704, KT = 17408, VT = 27648, GT = 48128, EL = 50176;
    const int tid = opaque_tid(), lane = tid & 63, r = lane & 15, g = lane >> 4, w = C.wave; unsigned char* ws = opaque_ws(C);
    const bf16* P = (const bf16*)(ws + WS_P);
    const int qcol = (GLA ? P_GQ : P_HQ) + h * 128, kcol = P_GK + h * 128, vcol = GLA ? (P_GV + h * 256) : (P_HI + h * 128), fld = GLA ? 512 : 1024;
    const float* gp = (const float*)(ws + (GLA ? WS_GF : WS_HF)) + (size_t)dir * M * fld + h * 128;
    bf16* op = (bf16*)(ws + (GLA ? WS_OSG : WS_OSH)) + (size_t)dir * M * 1024 + h * DV;
    LAS unsigned char* L = C.lds + RING_OFF;
    const size_t mb = (size_t)b * SEQ;
    const int ek = tid & 127, eg = tid >> 7;
    const int sv = GLA ? (tid & 255) : (tid & 127), sg0 = GLA ? (tid >> 8) : (tid >> 7);
#define CS_TOK(n, s) (dir ? (SEQ - 1 - (CH * (n) + (s))) : (CH * (n) + (s)))
    float gl[2][8]; bf16 qv[2][8], kv[2][8], vv[2][NVI][8];
#define CS_LOAD(hf, n) do { _Pragma("unroll") for (int e = 0; e < 8; ++e) { const size_t mrow = mb + CS_TOK(n, 8 * eg + e); gl[hf][e] = gp[mrow * fld + ek]; qv[hf][e] = P[mrow * NP + qcol + ek]; if (GLA) kv[hf][e] = P[mrow * NP + kcol + ek]; } \
        _Pragma("unroll") for (int i = 0; i < NVI; ++i) _Pragma("unroll") for (int e = 0; e < 8; ++e) vv[hf][i][e] = P[(mb + CS_TOK(n, 8 * (sg0 + 2 * i) + e)) * NP + vcol + sv]; } while (0)
    f32x4 S[8][NVJ];
#pragma unroll
    for (int kt = 0; kt < 8; ++kt)
#pragma unroll
        for (int vj = 0; vj < NVJ; ++vj) S[kt][vj] = (f32x4){0.f, 0.f, 0.f, 0.f};
    CS_LOAD(0, 0); CS_LOAD(1, 1);
    for (int n2 = 0; n2 < NCH; n2 += 2) {
#pragma unroll
    for (int hf = 0; hf < 2; ++hf) { const int n = n2 + hf;
        float c[8]; c[0] = gl[hf][0];
#pragma unroll
        for (int e = 1; e < 8; ++e) c[e] = c[e - 1] + gl[hf][e];
        *(LAS float*)(L + GT + (eg * 128 + ek) * 4) = c[7];
        LDS_WAIT(); __builtin_amdgcn_s_barrier(); asm volatile("" ::: "memory");
        float off = 0.f, glast = 0.f;
#pragma unroll
        for (int j = 0; j < 4; ++j) { const float t = *(const LAS float*)(L + GT + (j * 128 + ek) * 4); glast += t; off += (j < eg) ? t : 0.f; }
        f32x4 kh0, kh1; const float eL = __expf(glast);
#pragma unroll
        for (int e = 0; e < 8; ++e) {
            const float Gv = off + c[e];
            const float key = GLA ? bf1(kv[hf][e]) : (1.0f - __expf(gl[hf][e]));
            const float emG = __expf(fminf(-Gv, 80.0f));
            const float qt = bf1(qv[hf][e]) * __expf(Gv), kt = key * emG, kh = kt * eL;
            *(LAS unsigned short*)(L + QI + (8 * eg + e) * 272 + 2 * ek) = (unsigned short)(pk2(qt, qt) & 0xffffu);
            *(LAS unsigned short*)(L + KI + (8 * eg + e) * 272 + 2 * ek) = (unsigned short)(pk2(kt, kt) & 0xffffu);
            if (e < 4) kh0[e] = kh; else kh1[e - 4] = kh;
        }
        *(LAS sbf16x8*)(L + KT + ek * 80 + 16 * eg) = pack8(kh0, kh1);
        if (eg == 0) *(LAS float*)(L + EL + ek * 4) = eL;
#pragma unroll
        for (int i = 0; i < NVI; ++i) { v4u wv; wv.x = (unsigned)vv[hf][i][0] | ((unsigned)vv[hf][i][1] << 16); wv.y = (unsigned)vv[hf][i][2] | ((unsigned)vv[hf][i][3] << 16);
            wv.z = (unsigned)vv[hf][i][4] | ((unsigned)vv[hf][i][5] << 16); wv.w = (unsigned)vv[hf][i][6] | ((unsigned)vv[hf][i][7] << 16);
            *(LAS v4u*)(L + VT + sv * 80 + 16 * (sg0 + 2 * i)) = wv; }
        LDS_WAIT(); __builtin_amdgcn_s_barrier(); asm volatile("" ::: "memory");
        if (n + 2 < NCH) CS_LOAD(hf, n + 2);
        f32x4 AT00 = {0.f, 0.f, 0.f, 0.f}, AT01 = AT00, AT11 = AT00;
#pragma unroll
        for (int ks = 0; ks < 4; ++ks) {
            const sbf16x8 k0 = *(const LAS sbf16x8*)(L + KI + r * 272 + (32 * ks + 8 * g) * 2), k1 = *(const LAS sbf16x8*)(L + KI + (16 + r) * 272 + (32 * ks + 8 * g) * 2);
            const sbf16x8 q0 = *(const LAS sbf16x8*)(L + QI + r * 272 + (32 * ks + 8 * g) * 2), q1 = *(const LAS sbf16x8*)(L + QI + (16 + r) * 272 + (32 * ks + 8 * g) * 2);
            AT00 = MFMA16(k0, q0, AT00); AT01 = MFMA16(k0, q1, AT01); AT11 = MFMA16(k1, q1, AT11);
        }
#pragma unroll
        for (int e = 0; e < 4; ++e) { if (4 * g + e > r) { AT00[e] = 0.f; AT11[e] = 0.f; } }
        const f32x4 zero4 = {0.f, 0.f, 0.f, 0.f};
        const sbf16x8 PA0 = pack8(AT00, zero4), PA1 = pack8(AT01, AT11);
        f32x4 O[2][NVJ];
#pragma unroll
        for (int vj = 0; vj < NVJ; ++vj) {
            const int vrow = 16 * (NVJ * w + vj) + r;
            const sbf16x8 vperm = cat64(*(const LAS v2u*)(L + VT + vrow * 80 + 8 * g), *(const LAS v2u*)(L + VT + vrow * 80 + 32 + 8 * g));
            O[0][vj] = MFMA16(PA0, vperm, zero4); O[1][vj] = MFMA16(PA1, vperm, zero4);
        }
#pragma unroll
        for (int ks = 0; ks < 4; ++ks) {
            const sbf16x8 qp0 = cat64(*(const LAS v2u*)(L + QI + r * 272 + (32 * ks + 4 * g) * 2), *(const LAS v2u*)(L + QI + r * 272 + (32 * ks + 16 + 4 * g) * 2));
            const sbf16x8 qp1 = cat64(*(const LAS v2u*)(L + QI + (16 + r) * 272 + (32 * ks + 4 * g) * 2), *(const LAS v2u*)(L + QI + (16 + r) * 272 + (32 * ks + 16 + 4 * g) * 2));
#pragma unroll
            for (int vj = 0; vj < NVJ; ++vj) { const sbf16x8 sf = pack8(S[2 * ks][vj], S[2 * ks + 1][vj]);
                O[0][vj] = MFMA16(qp0, sf, O[0][vj]); O[1][vj] = MFMA16(qp1, sf, O[1][vj]); }
        }
#pragma unroll
        for (int tj = 0; tj < 2; ++tj)
#pragma unroll
            for (int vj = 0; vj < NVJ; ++vj)
#pragma unroll
                for (int e = 0; e < 4; ++e) { const float ov = O[tj][vj][e] * 0.088388347648318440f; op[(mb + CS_TOK(n, 16 * tj + 4 * g + e)) * 1024 + 16 * (NVJ * w + vj) + r] = (bf16)(pk2(ov, ov) & 0xffffu); }
#pragma unroll
        for (int kt = 0; kt < 8; ++kt) {
            const f32x4 dec = *(const LAS f32x4*)(L + EL + (16 * kt + 4 * g) * 4);
            const sbf16x8 kf = *(const LAS sbf16x8*)(L + KT + (16 * kt + r) * 80 + 16 * g);
#pragma unroll
            for (int vj = 0; vj < NVJ; ++vj) { const sbf16x8 vn = *(const LAS sbf16x8*)(L + VT + (16 * (NVJ * w + vj) + r) * 80 + 16 * g);
                S[kt][vj] = MFMA16(kf, vn, S[kt][vj] * dec); }
        }
    }
    }
    LDS_WAIT(); __syncthreads();
#undef CS_TOK
#undef CS_LOAD
}
constexpr int CW_Q = 8192;
constexpr int CONV_CHUNK = 64;
static_assert(I_EARLY % CONV_CHUNK == 0 && I_LATE % CONV_CHUNK == 0, "conversion chunks");
__device__ __forceinline__ void mixer_phase(Ctx& C, int l, unsigned char* lds_generic) {
    unsigned char* ws = opaque_ws(C);
    const att::bf16* QN = (const att::bf16*)(ws + WS_QN); const att::bf16* KN = (const att::bf16*)(ws + WS_KN); const att::bf16* VN = (const att::bf16*)(ws + WS_VN);
    att::bf16* O12 = (att::bf16*)(ws + WS_O12);
    unsigned* qbase = (unsigned*)(ws + WS_CTL) + CW_Q + 64 * 8 * l;
    volatile LAS unsigned* slot = (volatile LAS unsigned*)(C.lds + MISC_OFF);
    const int x0 = (int)(xb_xcc_id() & 7u);
    for (int k = 0; k < 8; ++k) {
        const int x = (x0 + k) & 7;
        for (;;) {
            if (threadIdx.x == 0) slot[0] = __hip_atomic_fetch_add(qbase + 64 * x, 1u, __ATOMIC_RELAXED, __HIP_MEMORY_SCOPE_AGENT);
            __syncthreads();
            const int li = (int)__builtin_amdgcn_readfirstlane(slot[0]);
            __syncthreads();
            if (li >= 6 + 64) break;
            if (li < 6) { const int item = x + 8 * li;
                if (item < 16) scan_chain<true>(C, item >> 3, (item >> 1) & 3, item & 1);
                else { const int it = item - 16; scan_chain<false>(C, it >> 4, (it >> 1) & 7, it & 1); } }
            else {
                const int ul = li - 6, qb = ul & 15, hm = 2 * x + ((ul >> 4) & 1), b = ul >> 5;
                const size_t row0 = (size_t)b * SEQ;
                att::attn256_body(QN + (row0 + qb * 256) * 2048 + hm * 128, KN + row0 * 2048 + hm * 128, VN + row0 * 2048 + (hm >> 1) * 256,
                                  O12 + (size_t)(hm & 1) * M * 2048 + (row0 + qb * 256) * 2048 + (hm >> 1) * 256, SEQ, (char*)lds_generic + RING_OFF);
                __syncthreads();
            }
        }
    }
    {
        const int lane = opaque_tid() & 63; LAS float* scr = (LAS float*)(C.lds + RING_OFF + C.wave * 8448);
        unsigned* chead = (unsigned*)(ws + WS_CTL) + CW_Q + 64 * (8 * NL + l);
        const int nchunks = (I_LATE + (l + 1 < NL ? I_EARLY : 0)) / CONV_CHUNK;
        for (;;) {
            if (threadIdx.x == 0) slot[0] = __hip_atomic_fetch_add(chead, 1u, __ATOMIC_RELAXED, __HIP_MEMORY_SCOPE_AGENT);
            __syncthreads();
            const int ch = (int)__builtin_amdgcn_readfirstlane(slot[0]);
            __syncthreads();
            if (ch >= nchunks) break;
            for (int i = 0; i < CONV_CHUNK / NWAVES; ++i) { const int idx = ch * CONV_CHUNK + C.wave + NWAVES * i;
                if (idx < I_LATE) conv_item(C, ws, l, I_EARLY + idx, scr, lane); else conv_item(C, ws, l + 1, idx - I_LATE, scr, lane); }
        }
    }
}

struct Args { const float* in[25]; float* out; unsigned char* ws; int ph_lo, ph_hi; };
__global__ void __launch_bounds__(NWAVES * 64, 2) mk_fwd(Args args) {
    extern __shared__ __attribute__((aligned(16))) unsigned char lds[];
    Ctx C;
    C.lds = (LAS unsigned char*)lds;
    C.wave = __builtin_amdgcn_readfirstlane((int)threadIdx.x >> 6);
    C.G = gridDim.x; { const int bx = blockIdx.x; C.vcu = (C.G % 8 == 0) ? (bx % 8) * (C.G / 8) + bx / 8 : bx; }
    C.gw = C.vcu * NWAVES + C.wave; C.ngw = C.G * NWAVES;
    C.in = args.in; C.out = args.out; C.ws = args.ws;
    volatile LAS unsigned* MISC = (volatile LAS unsigned*)(C.lds + MISC_OFF);
    for (int u = threadIdx.x; u < (LDS_BYTES - LDSCTL_OFF) / 4; u += NWAVES * 64) ((LAS unsigned*)(C.lds + LDSCTL_OFF))[u] = 0u;
    __syncthreads();
    gu32* ctl = (gu32*)(C.ws + WS_CTL);
    XcdBarrier bar; bar.bar = (unsigned*)(ctl + CW_BAR); bar.x = 0; bar.st = nullptr;
    if (!MK_PER_PHASE) bar = xcd_barrier_post((unsigned*)(ctl + CW_BAR), MISC + 8);
    const int lo = args.ph_lo, hi = args.ph_hi;
    int ph = 0;
#ifndef REP_PRO
#define REP_PRO 1
#endif
#ifndef REP_THIN
#define REP_THIN 1
#endif
#ifndef REP_G4
#define REP_G4 1
#endif
#ifndef REP_G1
#define REP_G1 1
#endif
#ifndef REP_G3
#define REP_G3 1
#endif
#ifndef REP_ATT
#define REP_ATT 1
#endif
#ifndef REP_SCAN
#define REP_SCAN 1
#endif
#ifndef MK_SITES
#define MK_SITES 0xffffffffu
#endif
#define SITE(k) (((MK_SITES) >> (k)) & 1u)
#define PH_ON (lo <= ph && ph < hi)
#define PH_END do { if (!MK_PER_PHASE && lo <= ph && ph + 1 < hi) { XcdBarrier b2 = bar; asm volatile("" : "+s"(b2.bar), "+s"(b2.x)); xcd_barrier(b2); } ++ph; } while (0)

    if (SITE(0) && PH_ON) for (int rep = 0; rep < REP_PRO; ++rep) prologue(C);
    PH_END;

    for (int l = 0; l < NL; ++l) {
#define WL(ws) ((const bf16*)((ws) + WS_W) + (size_t)l * LAYER_W)
        if (SITE(2) && PH_ON) for (int rep = 0; rep < REP_G1; ++rep) { unsigned char* ws = opaque_ws(C); pg8::Gemm g{(const bf16*)(ws + WS_H), WL(ws) + OW_1A, M, 2 * FF, DM}; pg8::StaticOrder S; S.init(M, 2 * FF, C.G, (int)blockIdx.x);
            pg8::EpiGlu E{(bf16*)(ws + WS_ACT), FF, (const unsigned long long*)(ws + WS_SS) + (size_t)(3 * l) * M, 1.0f / DM, EPS};
            pg8::gemm_phase<pg8::EpiGlu, pg8::StaticOrder, true, true>(C.lds + RING_OFF, g, S, E); }
        PH_END;
        if (SITE(3) && PH_ON) { unsigned char* ws = opaque_ws(C); pg8::Gemm g{(const bf16*)(ws + WS_ACT), WL(ws) + OW_1B, M, DM, FF}; pg8::StaticOrder S; S.init(M, DM, C.G, (int)blockIdx.x);
            pg8::EpiResid<false, false, true> E{nullptr, nullptr, (bf16*)(ws + WS_H), (unsigned long long*)(ws + WS_SS) + (size_t)(3 * l + 1) * M, DM, 0.5f, ws + WS_X8};
            pg8::gemm_phase<pg8::EpiResid<false, false, true>, pg8::StaticOrder, true, true>(C.lds + RING_OFF, g, S, E); }
        PH_END;
        if (SITE(5) && PH_ON) for (int rep = 0; rep < REP_G3; ++rep) {
            { unsigned char* ws = opaque_ws(C); pg8::Gemm g{(const bf16*)(ws + WS_H), WL(ws) + OW_IN, M, P_GA, DM}; pg8::StaticOrder S; S.init(M, P_GA, C.G, (int)blockIdx.x);
              pg8::EpiBf16Plain E{(bf16*)(ws + WS_P), NP, (const unsigned long long*)(ws + WS_SS) + (size_t)(3 * l + 1) * M, 1.0f / DM, EPS, (bf16*)(ws + WS_VN), 2048, P_AV / 256, P_GQ / 256, 1.0f};
              pg8::gemm_phase<pg8::EpiBf16Plain, pg8::StaticOrder, true, true>(C.lds + RING_OFF, g, S, E); }
            { unsigned char* ws = opaque_ws(C); pg8::Gemm g{(const bf16*)(ws + WS_X8), WL(ws) + OW_IN + OW8_OFF, M, NP - P_GA, DM / 2}; pg8::StaticOrder S; S.init(M, NP - P_GA, C.G, (int)blockIdx.x);
              pg8::EpiBf16Plain E{(bf16*)(ws + WS_P) + P_GA, NP, (const unsigned long long*)(ws + WS_SS) + (size_t)(3 * l + 1) * M, 1.0f / DM, EPS, nullptr, 0, 0, 0, 1.0f / W8_SCALE};
              pg8::gemm_phase<pg8::EpiBf16Plain, pg8::StaticOrder, true, true, true>(C.lds + RING_OFF, g, S, E); } }
        PH_END;
        if (SITE(6) && PH_ON) for (int rep = 0; rep < REP_THIN; ++rep) prep_phase(C, l);
        PH_END;
        if (SITE(7) && PH_ON) mixer_phase(C, l, lds);
        PH_END;
        if (SITE(8) && PH_ON) for (int rep = 0; rep < REP_THIN; ++rep) post_phase(C, l);
        PH_END;
        if (SITE(9) && PH_ON) for (int rep = 0; rep < REP_G4; ++rep) { unsigned char* ws = opaque_ws(C); pg8::Gemm g{(const bf16*)(ws + WS_OA), WL(ws) + OW_A, M, DM, DM}; pg8::StaticOrder S; S.init(M, DM, C.G, (int)blockIdx.x);
            pg8::EpiGate3 E{(const bf16*)(ws + WS_P) + P_GA, NP, P_GG - P_GA, P_GH - P_GA, (bf16*)(ws + WS_MB), DM, 2048 / 64, 3072 / 64};
            pg8::gemm_phase<pg8::EpiGate3, pg8::StaticOrder, true, true>(C.lds + RING_OFF, g, S, E); }
        PH_END;
        if (SITE(10) && PH_ON) { unsigned char* ws = opaque_ws(C); pg8::Gemm g{(const bf16*)(ws + WS_MB), WL(ws) + OW_O, M, DM, DM}; pg8::StaticOrder S; S.init(M, DM, C.G, (int)blockIdx.x);
            pg8::EpiResid<false, false> E{nullptr, nullptr, (bf16*)(ws + WS_H), (unsigned long long*)(ws + WS_SS) + (size_t)(3 * l + 2) * M, DM, 1.0f};
            pg8::gemm_phase<pg8::EpiResid<false, false>, pg8::StaticOrder, true, true>(C.lds + RING_OFF, g, S, E); }
        PH_END;
        if (SITE(12) && PH_ON) for (int rep = 0; rep < REP_G1; ++rep) { unsigned char* ws = opaque_ws(C); pg8::Gemm g{(const bf16*)(ws + WS_H), WL(ws) + OW_2A, M, 2 * FF, DM}; pg8::StaticOrder S; S.init(M, 2 * FF, C.G, (int)blockIdx.x);
            pg8::EpiGlu E{(bf16*)(ws + WS_ACT), FF, (const unsigned long long*)(ws + WS_SS) + (size_t)(3 * l + 2) * M, 1.0f / DM, EPS};
            pg8::gemm_phase<pg8::EpiGlu, pg8::StaticOrder, true, true>(C.lds + RING_OFF, g, S, E); }
        PH_END;
        if (SITE(13) && PH_ON) { unsigned char* ws = opaque_ws(C); pg8::Gemm g{(const bf16*)(ws + WS_ACT), WL(ws) + OW_2B, M, DM, FF}; pg8::StaticOrder S; S.init(M, DM, C.G, (int)blockIdx.x);
            if (l + 1 < NL) { pg8::EpiResid<false, false> E{nullptr, nullptr, (bf16*)(ws + WS_H), (unsigned long long*)(ws + WS_SS) + (size_t)(3 * l + 3) * M, DM, 0.5f};
                pg8::gemm_phase<pg8::EpiResid<false, false>, pg8::StaticOrder, true, true>(C.lds + RING_OFF, g, S, E); }
            else { pg8::EpiResid<false, true> E{nullptr, C.out, (bf16*)(ws + WS_H), nullptr, DM, 0.5f};
                pg8::gemm_phase<pg8::EpiResid<false, true>, pg8::StaticOrder, true, true>(C.lds + RING_OFF, g, S, E); } }
        PH_END;
#undef WL
    }
#undef PH_ON
#undef PH_END
}
constexpr int N_PHASES = 1 + 10 * NL;

extern "C" void kernel_launch(void* const* d_in, const int* in_sizes, int n_in, void* d_out, int out_size, void* d_ws, size_t ws_size, hipStream_t stream) {
    static int grid = 0;
    if (grid == 0) {
        if (n_in != 25 || in_sizes[0] != M * DM || out_size != M * DM || ws_size < WS_END) {
            fprintf(stderr, "kernel_launch: built for 25 inputs, x/out of %d floats, >= %zu bytes of workspace; got n_in %d, in0 %d, out %d, ws %zu; nothing launched\n", M * DM, (size_t)WS_END, n_in, n_in > 0 ? in_sizes[0] : -1, out_size, ws_size);
            grid = -1; return; }
        int dev = 0, cus = 0, per_cu = 0;
        if (hipGetDevice(&dev) != hipSuccess || hipDeviceGetAttribute(&cus, hipDeviceAttributeMultiprocessorCount, dev) != hipSuccess) { fprintf(stderr, "kernel_launch: device query failed\n"); grid = -1; return; }
        if (hipFuncSetAttribute((const void*)mk_fwd, hipFuncAttributeMaxDynamicSharedMemorySize, LDS_BYTES) != hipSuccess) { fprintf(stderr, "kernel_launch: hipFuncSetAttribute failed\n"); grid = -1; return; }
        if (hipOccupancyMaxActiveBlocksPerMultiprocessor(&per_cu, (const void*)mk_fwd, NWAVES * 64, LDS_BYTES) != hipSuccess || per_cu < 1)
            fprintf(stderr, "kernel_launch: note: occupancy query reports %d workgroups per CU\n", per_cu);
        (void)hipGetLastError();
        grid = cus;
    }
    if (grid < 0) return;
    if (hipMemsetAsync((char*)d_ws + WS_CTL, 0, CTL_ZERO_BYTES, stream) != hipSuccess) { fprintf(stderr, "kernel_launch: memset failed\n"); return; }
    Args a{};
    for (int i = 0; i < 25; ++i) a.in[i] = (const float*)d_in[i];
    a.out = (float*)d_out; a.ws = (unsigned char*)d_ws;
#if MK_PER_PHASE
    for (int p = 0; p < N_PHASES; ++p) { a.ph_lo = p; a.ph_hi = p + 1; hipLaunchKernelGGL(mk_fwd, dim3(grid), dim3(NWAVES * 64), LDS_BYTES, stream, a); }
#else
    a.ph_lo = 0; a.ph_hi = N_PHASES;
    hipLaunchKernelGGL(mk_fwd, dim3(grid), dim3(NWAVES * 64), LDS_BYTES, stream, a);
#endif
    const hipError_t le = hipPeekAtLastError();
    if (le != hipSuccess) fprintf(stderr, "kernel_launch: launch failed: %s\n", hipGetErrorName(le));
}
```

```cpp
#include <hip/hip_runtime.h>
#include <hip/hip_bf16.h>
#include <cstdio>
#include <cstdint>
namespace pg8 {
#define PG8_LAS __attribute__((address_space(3)))
typedef unsigned short bf16_t;
typedef short bf16x8 __attribute__((ext_vector_type(8)));
typedef float f32x4 __attribute__((ext_vector_type(4)));
typedef unsigned u32x4 __attribute__((ext_vector_type(4)));
constexpr int BM = 256, BK = 64, HALF = 128, HTB = HALF * BK * 2  , STAGE_BYTES = 8 * HTB, NXCD = 8, WGM = 4;

__host__ __device__ __forceinline__ int lds_byte(int r, int c) { const int st = (r >> 4) * 2 + (c >> 5), rr = r & 15, cc = c & 31, ob = rr * 64 + cc * 2; return st * 1024 + (ob ^ (((ob >> 9) & 1) << 5)); }
__host__ __device__ __forceinline__ void stage_rc(int b, int& R, int& C) { const int st = b / 1024, sb = b % 1024, swz = sb ^ (((sb >> 9) & 1) << 5); R = (st >> 1) * 16 + swz / 64; C = (st & 1) * 32 + (swz % 64) / 2; }
__host__ __device__ __forceinline__ int perm32(int rho) { const int n = rho >> 4, i = rho & 15; return 8 * (i >> 2) + 4 * n + (i & 3); }

struct Unit { int pm, pn; };
struct Gemm { const bf16_t* A; const bf16_t* Bt; int M, N, K; };

struct StaticOrder {
    int nM, nN, nwg, G, c;
    __host__ __device__ void init(int M, int N, int G_, int c_) { nM = M / BM; nN = N / BM; nwg = nM * nN; G = G_; c = c_; }
    __host__ __device__ bool next(int i, Unit& u) const {
        const long L = (long)i * G + c; if (L >= nwg) return false;
        int wgid = (int)L; { const int q = nwg / NXCD, r = nwg % NXCD, xcd = wgid % NXCD, off = wgid / NXCD; wgid = (xcd < r ? xcd * (q + 1) : r * (q + 1) + (xcd - r) * q) + off; }
        const int nig = WGM * nN, gid = wgid / nig, fm = gid * WGM, gsz = (nM - fm) < WGM ? (nM - fm) : WGM;
        u.pm = fm + ((wgid % nig) % gsz); u.pn = (wgid % nig) / gsz; return true;
    }
    __device__ __forceinline__ void a_ready(const Unit&) const {}
    __device__ __forceinline__ void done(const Unit&) const {}
};

__device__ __forceinline__ unsigned cvt_pk_bf16(float lo, float hi) { unsigned r; asm volatile("v_cvt_pk_bf16_f32 %0, %1, %2" : "=v"(r) : "v"(lo), "v"(hi)); return r; }
typedef float f32x2 __attribute__((ext_vector_type(2)));
typedef unsigned u32x2 __attribute__((ext_vector_type(2)));
__device__ __forceinline__ float sigmoid_fast(float x) { return __builtin_amdgcn_rcpf(1.0f + __builtin_amdgcn_exp2f(-1.4426950408889634f * x)); }
__device__ __forceinline__ float bf_lo(unsigned w) { return __uint_as_float(w << 16); }
__device__ __forceinline__ float bf_hi(unsigned w) { return __uint_as_float(w & 0xffff0000u); }

struct EpiGlu {
    static constexpr bool PERM = true, AFTER_DRAIN = false, KHOOK = false;
    bf16_t* O; int ldc; const unsigned long long* ss; float inv_n, eps;
    __device__ __forceinline__ void operator()(const f32x4 (&acc)[2][2][4][2], const Unit& u, int wr, int wc, int fr, int fq) const {
        const int row0 = u.pm * BM + wr * 64 + fr, col0 = u.pn * HALF + wc * 32 + 8 * fq;
        unsigned long long sv[8];
#pragma unroll
        for (int rg = 0; rg < 8; ++rg) sv[rg] = ss[row0 + (rg >> 2) * HALF + (rg & 3) * 16];
#pragma unroll
        for (int ai = 0; ai < 2; ++ai)
#pragma unroll
            for (int m = 0; m < 4; ++m) { const int row = row0 + ai * HALF + m * 16; bf16_t* rowp = O + (size_t)row * ldc + col0;
                const float rs = __builtin_amdgcn_rsqf((float)sv[ai * 4 + m] * (1.0f / 1048576.0f) * inv_n + eps);
                f32x4 v0, v1;
#pragma unroll
                for (int j = 0; j < 4; ++j) { const float g0 = acc[ai][0][m][0][j] * rs, g1 = acc[ai][0][m][1][j] * rs;
                    v0[j] = g0 * sigmoid_fast(g0) * (acc[ai][1][m][0][j] * rs); v1[j] = g1 * sigmoid_fast(g1) * (acc[ai][1][m][1][j] * rs); }
                u32x4 w; w.x = cvt_pk_bf16(v0[0], v0[1]); w.y = cvt_pk_bf16(v0[2], v0[3]); w.z = cvt_pk_bf16(v1[0], v1[1]); w.w = cvt_pk_bf16(v1[2], v1[3]);
                *(u32x4*)rowp = w; }
    }
};
template <bool BASE_F32, bool OUT_F32, bool W8 = false> struct EpiResid {
    static constexpr bool PERM = true, AFTER_DRAIN = false, KHOOK = false;
    const float* basef; float* out; bf16_t* xb; unsigned long long* ss; int ldc; float s; unsigned char* x8;
    __device__ __forceinline__ void operator()(const f32x4 (&acc)[2][2][4][2], const Unit& u, int wr, int wc, int fr, int fq) const {
        const int row0 = u.pm * BM + wr * 64 + fr, col0 = u.pn * BM + wc * 32 + 8 * fq;
        u32x4 bw[8][2];
        if (!BASE_F32 && !W8) {
#pragma unroll
            for (int rg = 0; rg < 8; ++rg)
#pragma unroll
                for (int bj = 0; bj < 2; ++bj) bw[rg][bj] = *(const u32x4*)(xb + (size_t)(row0 + (rg >> 2) * HALF + (rg & 3) * 16) * ldc + col0 + bj * HALF);
        }
#pragma unroll
        for (int rg = 0; rg < 8; ++rg) { const int ai = rg >> 2, m = rg & 3; const int row = row0 + ai * HALF + m * 16; const size_t off = (size_t)row * ldc + col0; float q2 = 0.f;
            if (!BASE_F32 && W8 && m == 0) {
#pragma unroll
                for (int r2 = 0; r2 < 4; ++r2)
#pragma unroll
                    for (int bj = 0; bj < 2; ++bj) bw[rg + r2][bj] = *(const u32x4*)(xb + (size_t)(row0 + ai * HALF + r2 * 16) * ldc + col0 + bj * HALF);
                asm volatile("" ::: "memory"); }
#pragma unroll
            for (int bj = 0; bj < 2; ++bj) { f32x4 b0, b1;
                if (BASE_F32) { b0 = *(const f32x4*)(basef + off + bj * HALF); b1 = *(const f32x4*)(basef + off + bj * HALF + 4); }
                else { const u32x4 w = bw[rg][bj]; b0 = (f32x4){bf_lo(w.x), bf_hi(w.x), bf_lo(w.y), bf_hi(w.y)}; b1 = (f32x4){bf_lo(w.z), bf_hi(w.z), bf_lo(w.w), bf_hi(w.w)}; }
                const f32x4 o0 = b0 + acc[ai][bj][m][0] * s, o1 = b1 + acc[ai][bj][m][1] * s;
                q2 += ((o0[0] * o0[0] + o0[1] * o0[1]) + (o0[2] * o0[2] + o0[3] * o0[3])) + ((o1[0] * o1[0] + o1[1] * o1[1]) + (o1[2] * o1[2] + o1[3] * o1[3]));
                if (OUT_F32) { *(f32x4*)(out + off + bj * HALF) = o0; *(f32x4*)(out + off + bj * HALF + 4) = o1; }
                else { u32x4 w; w.x = cvt_pk_bf16(o0[0], o0[1]); w.y = cvt_pk_bf16(o0[2], o0[3]); w.z = cvt_pk_bf16(o1[0], o1[1]); w.w = cvt_pk_bf16(o1[2], o1[3]); *(u32x4*)(xb + off + bj * HALF) = w; }
                if (W8) { int lo = __builtin_amdgcn_cvt_pk_fp8_f32(o0[0], o0[1], 0, false); lo = __builtin_amdgcn_cvt_pk_fp8_f32(o0[2], o0[3], lo, true);
                    int hi = __builtin_amdgcn_cvt_pk_fp8_f32(o1[0], o1[1], 0, false); hi = __builtin_amdgcn_cvt_pk_fp8_f32(o1[2], o1[3], hi, true);
                    *(u32x2*)(x8 + off + bj * HALF) = (u32x2){(unsigned)lo, (unsigned)hi}; } }
            if (!OUT_F32) { q2 += __shfl_xor(q2, 16); q2 += __shfl_xor(q2, 32);
                if (fq == 0) __hip_atomic_fetch_add(ss + row, (unsigned long long)(q2 * 1048576.0f + 0.5f), __ATOMIC_RELAXED, __HIP_MEMORY_SCOPE_AGENT); }
        }
    }
};
struct EpiBf16Plain {
    static constexpr bool PERM = true, AFTER_DRAIN = false, KHOOK = false;
    bf16_t* O; int ldc; const unsigned long long* ss; float inv_n, eps; bf16_t* O2; int ld2, t0, t1; float cs;
    __device__ __forceinline__ void operator()(const f32x4 (&acc)[2][2][4][2], const Unit& u, int wr, int wc, int fr, int fq) const {
        const bool redir = u.pn >= t0 && u.pn < t1;
        bf16_t* base = redir ? O2 : O; const int ld = redir ? ld2 : ldc;
        const int row0 = u.pm * BM + wr * 64 + fr, col0 = (redir ? u.pn - t0 : u.pn) * BM + wc * 32 + 8 * fq;
        unsigned long long sv[8];
#pragma unroll
        for (int rg = 0; rg < 8; ++rg) sv[rg] = ss[row0 + (rg >> 2) * HALF + (rg & 3) * 16];
#pragma unroll
        for (int ai = 0; ai < 2; ++ai)
#pragma unroll
            for (int m = 0; m < 4; ++m) { const int row = row0 + ai * HALF + m * 16; bf16_t* rowp = base + (size_t)row * ld + col0;
                const float rs = __builtin_amdgcn_rsqf((float)sv[ai * 4 + m] * (1.0f / 1048576.0f) * inv_n + eps) * cs;
#pragma unroll
                for (int bj = 0; bj < 2; ++bj) { const f32x4 v0 = acc[ai][bj][m][0] * rs, v1 = acc[ai][bj][m][1] * rs;
                    u32x4 w; w.x = cvt_pk_bf16(v0[0], v0[1]); w.y = cvt_pk_bf16(v0[2], v0[3]); w.z = cvt_pk_bf16(v1[0], v1[1]); w.w = cvt_pk_bf16(v1[2], v1[3]);
                    *(u32x4*)(rowp + bj * HALF) = w; } }
    }
};
struct EpiGate3 {
    static constexpr bool PERM = true, AFTER_DRAIN = false, KHOOK = true;
    const bf16_t* G; int ldg; int goff_g, goff_h; bf16_t* Mb; int ldc; int t1, t2;
    static __device__ __forceinline__ float em(float x) { return __builtin_amdgcn_exp2f(-1.4426950408889634f * fminf(fmaxf(x, -30.0f), 30.0f)); }
    __device__ __forceinline__ void khook(f32x4 (&acc)[2][2][4][2], const Unit& u, bool second, int wr, int wc, int fr, int fq) const {
        const int row0 = u.pm * BM + wr * 64 + fr, col0 = u.pn * BM + wc * 32 + 8 * fq;
        const bf16_t* gnum = G + (second ? goff_g : 0) + (size_t)row0 * ldg + col0;
        const bf16_t* gden = G + (second ? goff_h : goff_g) + (size_t)row0 * ldg + col0;
        u32x4 cn[2], cd[2], nn[2], nd[2];
#pragma unroll
        for (int bj = 0; bj < 2; ++bj) { cn[bj] = *(const u32x4*)(gnum + bj * HALF); cd[bj] = *(const u32x4*)(gden + bj * HALF); }
#pragma unroll
        for (int rg = 0; rg < 8; ++rg) { const int ai = rg >> 2, m = rg & 3;
            if (rg < 7) { const size_t ro = (size_t)(((rg + 1) >> 2) * HALF + ((rg + 1) & 3) * 16) * ldg;
#pragma unroll
                for (int bj = 0; bj < 2; ++bj) { nn[bj] = *(const u32x4*)(gnum + ro + bj * HALF); nd[bj] = *(const u32x4*)(gden + ro + bj * HALF); } }
            asm volatile("" ::: "memory");
#pragma unroll
            for (int bj = 0; bj < 2; ++bj) { const unsigned an[4] = {cn[bj].x, cn[bj].y, cn[bj].z, cn[bj].w}, ad[4] = {cd[bj].x, cd[bj].y, cd[bj].z, cd[bj].w};
#pragma unroll
                for (int p = 0; p < 4; ++p) {
                    const float r0 = (1.0f + em(bf_lo(ad[p]))) * __builtin_amdgcn_rcpf(1.0f + em(bf_lo(an[p]))), r1 = (1.0f + em(bf_hi(ad[p]))) * __builtin_amdgcn_rcpf(1.0f + em(bf_hi(an[p])));
                    acc[ai][bj][m][p >> 1][2 * (p & 1)] *= r0; acc[ai][bj][m][p >> 1][2 * (p & 1) + 1] *= r1; } }
#pragma unroll
            for (int bj = 0; bj < 2; ++bj) { cn[bj] = nn[bj]; cd[bj] = nd[bj]; } }
    }
    __device__ __forceinline__ void operator()(const f32x4 (&acc)[2][2][4][2], const Unit& u, int wr, int wc, int fr, int fq) const {
        const int row0 = u.pm * BM + wr * 64 + fr, col0 = u.pn * BM + wc * 32 + 8 * fq;
        const bf16_t* gh = G + goff_h + (size_t)row0 * ldg + col0;
        u32x4 cg[2], ng[2];
#pragma unroll
        for (int bj = 0; bj < 2; ++bj) cg[bj] = *(const u32x4*)(gh + bj * HALF);
#pragma unroll
        for (int rg = 0; rg < 8; ++rg) { const int ai = rg >> 2, m = rg & 3; const size_t ro = (size_t)(ai * HALF + m * 16); bf16_t* rowp = Mb + (size_t)(row0 + ro) * ldc + col0;
            if (rg < 7) { const size_t rn = (size_t)(((rg + 1) >> 2) * HALF + ((rg + 1) & 3) * 16) * ldg;
#pragma unroll
                for (int bj = 0; bj < 2; ++bj) ng[bj] = *(const u32x4*)(gh + rn + bj * HALF); }
            asm volatile("" ::: "memory");
#pragma unroll
            for (int bj = 0; bj < 2; ++bj) { const unsigned ag[4] = {cg[bj].x, cg[bj].y, cg[bj].z, cg[bj].w};
                float o[8];
#pragma unroll
                for (int p = 0; p < 4; ++p) { o[2 * p] = acc[ai][bj][m][p >> 1][2 * (p & 1)] * __builtin_amdgcn_rcpf(1.0f + em(bf_lo(ag[p]))); o[2 * p + 1] = acc[ai][bj][m][p >> 1][2 * (p & 1) + 1] * __builtin_amdgcn_rcpf(1.0f + em(bf_hi(ag[p]))); }
                u32x4 w; w.x = cvt_pk_bf16(o[0], o[1]); w.y = cvt_pk_bf16(o[2], o[3]); w.z = cvt_pk_bf16(o[4], o[5]); w.w = cvt_pk_bf16(o[6], o[7]);
                *(u32x4*)(rowp + bj * HALF) = w; }
#pragma unroll
            for (int bj = 0; bj < 2; ++bj) cg[bj] = ng[bj]; }
    }
};

typedef int pg8_v8i __attribute__((ext_vector_type(8)));
typedef int pg8_v4i __attribute__((ext_vector_type(4)));
__device__ __forceinline__ pg8_v8i pg8_cat(bf16x8 lo, bf16x8 hi) { const pg8_v4i a = __builtin_bit_cast(pg8_v4i, lo), b = __builtin_bit_cast(pg8_v4i, hi); return (pg8_v8i){a[0], a[1], a[2], a[3], b[0], b[1], b[2], b[3]}; }
template <class Epi, class Sched, bool ALIGN_EPI = false, bool SP2 = false, bool FP8 = false>
__device__ __forceinline__ void gemm_phase(PG8_LAS unsigned char* lds, const Gemm g, const Sched& S, const Epi& E) {
    int tid_ = threadIdx.x; asm volatile("" : "+v"(tid_));
    const int tid = tid_, wid = __builtin_amdgcn_readfirstlane(tid >> 6), lane = tid & 63, wr = wid >> 2, wc = wid & 3, fr = lane & 15, fq = lane >> 4;
    const int K = g.K, nt = K / BK;
    unsigned voffA[2], voffB[2];
#pragma unroll
    for (int i = 0; i < 2; ++i) { int R, C; stage_rc(tid * 16 + i * 8192, R, C); const int Rb = Epi::PERM ? ((R & ~31) + perm32(R & 31)) : R;
        voffA[i] = (unsigned)(R * K + C) * 2u; voffB[i] = (unsigned)(Rb * K + C) * 2u; }
    const size_t kstep = (size_t)(BK * 2);
    const size_t hstep = (size_t)HALF * K * 2;
    const size_t tstep = 2 * hstep;
    const unsigned ldsw = (unsigned)wid * 1024u;
    const int aoff = lds_byte(wr * 64 + fr, fq * 8), boff = lds_byte(wc * 32 + fr, fq * 8);
#define PG8_SA(b, h) (((b) * 2 + (h)) * HTB)
#define PG8_SB(b, h) ((4 + (b) * 2 + (h)) * HTB)
#define PG8_STAGE(bufoff, gbase, voff) do { _Pragma("unroll") for (int _i = 0; _i < 2; ++_i) \
        __builtin_amdgcn_global_load_lds((const unsigned*)((const char*)(gbase) + (voff)[_i]), (PG8_LAS unsigned*)(lds + (bufoff) + ldsw + _i * 8192), 16, 0, 0); } while (0)
#define PG8_LDA(dst, b, h) do { _Pragma("unroll") for (int m = 0; m < 4; ++m) _Pragma("unroll") for (int k = 0; k < 2; ++k) dst[m][k] = *(const PG8_LAS bf16x8*)(lds + PG8_SA(b, h) + aoff + m * 2048 + k * 1024); } while (0)
#define PG8_LDB(dst, b, h) do { _Pragma("unroll") for (int n = 0; n < 2; ++n) _Pragma("unroll") for (int k = 0; k < 2; ++k) dst[n][k] = *(const PG8_LAS bf16x8*)(lds + PG8_SB(b, h) + boff + n * 2048 + k * 1024); } while (0)
#define PG8_MMA(ai, bj, At, Bt) do { __builtin_amdgcn_s_setprio(1); if constexpr (FP8) { _Pragma("unroll") for (int m = 0; m < 4; ++m) _Pragma("unroll") for (int n = 0; n < 2; ++n) \
        { const pg8_v8i a8_ = pg8_cat(Bt[n][0], Bt[n][1]), b8_ = pg8_cat(At[m][0], At[m][1]);   \
          asm volatile("v_mfma_scale_f32_16x16x128_f8f6f4 %0, %1, %2, %0, %3, %3 op_sel_hi:[0,0,0]" : "+v"(acc[ai][bj][m][n]) : "v"(a8_), "v"(b8_), "v"(pg8_one)); } } else { \
        _Pragma("unroll") for (int m = 0; m < 4; ++m) _Pragma("unroll") for (int n = 0; n < 2; ++n) _Pragma("unroll") for (int k = 0; k < 2; ++k) \
        acc[ai][bj][m][n] = __builtin_amdgcn_mfma_f32_16x16x32_bf16(Bt[n][k], At[m][k], acc[ai][bj][m][n], 0, 0, 0); } __builtin_amdgcn_s_setprio(0); } while (0)
#define PG8_WAIT_V(n) asm volatile("s_waitcnt vmcnt(" #n ")" ::: "memory")
#define PG8_WAIT_L(n) asm volatile("s_waitcnt lgkmcnt(" #n ")" ::: "memory")
#define PG8_BAR __builtin_amdgcn_s_barrier()
#define PG8_SCHED __builtin_amdgcn_sched_barrier(0)
    Unit cur, nxt; int ui = 0;
    if (!S.next(0, cur)) return;
    const int pg8_one = 0x7f7f7f7f;
    f32x4 acc[2][2][4][2];
#pragma unroll
    for (int a = 0; a < 2; ++a)
#pragma unroll
        for (int b = 0; b < 2; ++b)
#pragma unroll
            for (int m = 0; m < 4; ++m)
#pragma unroll
                for (int n = 0; n < 2; ++n) acc[a][b][m][n] = (f32x4){0.f, 0.f, 0.f, 0.f};
    bf16x8 At[4][2], B0[2][2], B1[2][2];
    const char* cA = (const char*)g.A + (size_t)cur.pm * tstep; const char* cB = (const char*)g.Bt + (size_t)cur.pn * tstep;
    S.a_ready(cur);
    if constexpr (SP2) {
        PG8_STAGE(PG8_SB(0, 0), cB, voffB); PG8_STAGE(PG8_SB(0, 1), cB + hstep, voffB); PG8_STAGE(PG8_SA(0, 0), cA, voffA); PG8_STAGE(PG8_SA(0, 1), cA + hstep, voffA);
        if (wr == 1) PG8_BAR;
        PG8_WAIT_V(2); PG8_BAR;
        PG8_STAGE(PG8_SB(1, 0), cB + kstep, voffB); PG8_STAGE(PG8_SA(1, 0), cA + kstep, voffA); PG8_STAGE(PG8_SB(1, 1), cB + hstep + kstep, voffB);
        PG8_WAIT_V(6); PG8_BAR;
    } else {
        PG8_STAGE(PG8_SB(0, 0), cB, voffB); PG8_STAGE(PG8_SA(0, 0), cA, voffA); PG8_STAGE(PG8_SB(0, 1), cB + hstep, voffB); PG8_STAGE(PG8_SA(0, 1), cA + hstep, voffA);
        if (wr == 1) PG8_BAR;
        PG8_WAIT_V(4); PG8_BAR;
        PG8_STAGE(PG8_SB(1, 0), cB + kstep, voffB); PG8_STAGE(PG8_SA(1, 0), cA + kstep, voffA); PG8_STAGE(PG8_SB(1, 1), cB + hstep + kstep, voffB);
        PG8_WAIT_V(6); PG8_BAR;
    }
    for (;;) {
        const bool has_next = S.next(ui + 1, nxt);
        const char* nA = has_next ? (const char*)g.A + (size_t)nxt.pm * tstep : cA; const char* nB = has_next ? (const char*)g.Bt + (size_t)nxt.pn * tstep : cB;
        for (int t = 0; t < nt; t += 2) {
            const bool last = (t == nt - 2);
            const char* a1 = cA + (size_t)(t + 1) * kstep;
            const char* a2 = last ? nA : cA + (size_t)(t + 2) * kstep; const char* b2 = last ? nB : cB + (size_t)(t + 2) * kstep;
            const char* a3 = a2 + kstep; const char* b3 = b2 + kstep;
            if (last && has_next) S.a_ready(nxt);
            if constexpr (Epi::KHOOK) { if (t == E.t1 || t == E.t2) E.khook(acc, cur, t == E.t2, wr, wc, fr, fq); }
            if constexpr (SP2) {
            PG8_LDB(B0, 0, 0); PG8_LDB(B1, 0, 1); PG8_SCHED; PG8_LDA(At, 0, 0); PG8_STAGE(PG8_SA(1, 1), a1 + hstep, voffA);
            PG8_WAIT_V(8); PG8_WAIT_L(0); PG8_BAR; PG8_MMA(0, 0, At, B0); PG8_MMA(0, 1, At, B1); PG8_BAR; PG8_SCHED;
            PG8_LDA(At, 0, 1); PG8_STAGE(PG8_SB(0, 0), b2, voffB); PG8_STAGE(PG8_SB(0, 1), b2 + hstep, voffB); PG8_STAGE(PG8_SA(0, 0), a2, voffA);
            PG8_WAIT_V(8); PG8_WAIT_L(0); PG8_BAR; PG8_MMA(1, 0, At, B0); PG8_MMA(1, 1, At, B1); PG8_BAR; PG8_SCHED;
            PG8_LDB(B0, 1, 0); PG8_LDB(B1, 1, 1); PG8_SCHED; PG8_LDA(At, 1, 0); PG8_STAGE(PG8_SA(0, 1), a2 + hstep, voffA);
            PG8_WAIT_V(8); PG8_WAIT_L(0); PG8_BAR; PG8_MMA(0, 0, At, B0); PG8_MMA(0, 1, At, B1); PG8_BAR; PG8_SCHED;
            PG8_LDA(At, 1, 1); PG8_STAGE(PG8_SB(1, 0), b3, voffB); PG8_STAGE(PG8_SB(1, 1), b3 + hstep, voffB); PG8_STAGE(PG8_SA(1, 0), a3, voffA);
            PG8_WAIT_V(8); PG8_WAIT_L(0); PG8_BAR; PG8_MMA(1, 0, At, B0); PG8_MMA(1, 1, At, B1); PG8_BAR; PG8_SCHED;
            } else {
            PG8_LDB(B0, 0, 0); PG8_SCHED; PG8_LDA(At, 0, 0); PG8_STAGE(PG8_SA(1, 1), a1 + hstep, voffA);
            PG8_WAIT_L(8); PG8_BAR; PG8_WAIT_L(0); PG8_MMA(0, 0, At, B0); PG8_BAR; PG8_SCHED;
            PG8_LDB(B1, 0, 1); PG8_STAGE(PG8_SB(0, 0), b2, voffB);
            PG8_BAR; PG8_WAIT_L(0); PG8_MMA(0, 1, At, B1); PG8_BAR;
            PG8_LDA(At, 0, 1); PG8_STAGE(PG8_SA(0, 0), a2, voffA);
            PG8_BAR; PG8_WAIT_L(0); PG8_MMA(1, 0, At, B0); PG8_BAR; PG8_SCHED;
            PG8_STAGE(PG8_SB(0, 1), b2 + hstep, voffB);
            PG8_WAIT_V(6); PG8_BAR; PG8_MMA(1, 1, At, B1); PG8_BAR;
            PG8_LDB(B0, 1, 0); PG8_SCHED; PG8_LDA(At, 1, 0); PG8_STAGE(PG8_SA(0, 1), a2 + hstep, voffA);
            PG8_WAIT_L(8); PG8_BAR; PG8_WAIT_L(0); PG8_MMA(0, 0, At, B0); PG8_BAR; PG8_SCHED;
            PG8_LDB(B1, 1, 1); PG8_STAGE(PG8_SB(1, 0), b3, voffB);
            PG8_BAR; PG8_WAIT_L(0); PG8_MMA(0, 1, At, B1); PG8_BAR;
            PG8_LDA(At, 1, 1); PG8_STAGE(PG8_SA(1, 0), a3, voffA);
            PG8_BAR; PG8_WAIT_L(0); PG8_MMA(1, 0, At, B0); PG8_BAR; PG8_SCHED;
            PG8_STAGE(PG8_SB(1, 1), b3 + hstep, voffB);
            PG8_WAIT_V(6); PG8_BAR; PG8_MMA(1, 1, At, B1); PG8_BAR;
            }
        }
        if constexpr (ALIGN_EPI) { if (wr == 0) PG8_BAR; }
        if constexpr (!Epi::AFTER_DRAIN) { E(acc, cur, wr, wc, fr, fq); S.done(cur); }
        if (!has_next) break;
#pragma unroll
        for (int a = 0; a < 2; ++a)
#pragma unroll
            for (int b = 0; b < 2; ++b)
#pragma unroll
                for (int m = 0; m < 4; ++m)
#pragma unroll
                    for (int n = 0; n < 2; ++n) acc[a][b][m][n] = (f32x4){0.f, 0.f, 0.f, 0.f};
        cur = nxt; cA = nA; cB = nB; ++ui;
        if constexpr (ALIGN_EPI) { if (wr == 1) PG8_BAR; }
    }
    PG8_WAIT_V(0);
    if constexpr (!ALIGN_EPI) { if (wr == 0) PG8_BAR; }
    PG8_BAR;
    if constexpr (Epi::AFTER_DRAIN) { E.fused(acc, cur, wr, wc, fr, fq, lds, wid, lane); S.done(cur); }
#undef PG8_SA
#undef PG8_SB
#undef PG8_STAGE
#undef PG8_LDA
#undef PG8_LDB
#undef PG8_MMA
#undef PG8_WAIT_V
#undef PG8_WAIT_L
#undef PG8_BAR
#undef PG8_SCHED
}
}
namespace att {
using bf16 = __hip_bfloat16;
constexpr int   D = 128, NW = 8, QBLK = 32, KVBLK = 64;
constexpr float SCALE = 0.088388347648318440f;
constexpr float THR = 8.f;
constexpr int SDEPTH = 1;
constexpr int LDQ = 2048, LDK = 2048, LDO = 2048;
constexpr size_t SHM_V = KVBLK * D * 2, SHM_K = KVBLK * D * 2, SHM_ATTN = 2 * SHM_V + 2 * SHM_K + NW * 64 * 4;
using bf16x8 = __attribute__((ext_vector_type(8))) short;
using s16x4  = __attribute__((ext_vector_type(4))) short;
using f32x16 = __attribute__((ext_vector_type(16))) float;
using f32x8  = __attribute__((ext_vector_type(8))) float;
using u32x4  = __attribute__((ext_vector_type(4))) unsigned;
#define KSWZ(row, colB) ((row) * 256 + ((colB) ^ (((row) & 7) << 4)))
#define SBAR() __builtin_amdgcn_sched_barrier(0)
__device__ __forceinline__ int crow(int r, int hi) { return (r & 3) + 8 * (r >> 2) + 4 * hi; }
__device__ __forceinline__ unsigned cvtpk(float lo, float hi) {
  unsigned r; asm volatile("v_cvt_pk_bf16_f32 %0, %1, %2" : "=v"(r) : "v"(lo), "v"(hi)); return r;
}
template <typename TIn> struct Stage;
template <> struct Stage<bf16>  { using T = bf16x8;
  __device__ static __forceinline__ T ld8(const bf16* p) { return *reinterpret_cast<const bf16x8*>(p); }
  __device__ static __forceinline__ bf16x8 tobf(T x) { return x; } };
template <> struct Stage<float> { using T = f32x8;
  __device__ static __forceinline__ T ld8(const float* p) { return *reinterpret_cast<const f32x8*>(p); }
  __device__ static __forceinline__ bf16x8 tobf(T x) {
    u32x4 w = {cvtpk(x[0], x[1]), cvtpk(x[2], x[3]), cvtpk(x[4], x[5]), cvtpk(x[6], x[7])}; return *reinterpret_cast<bf16x8*>(&w); } };

__device__ __forceinline__ void partialSM(f32x16& p0, f32x16& p1, float& m_reg, float& mn, float& alpha) {
  constexpr float C = SCALE * 1.4426950408889634f;
  float pmax = p0[0]; for (int r = 1; r < 16; ++r) pmax = fmaxf(pmax, p0[r]); for (int r = 0; r < 16; ++r) pmax = fmaxf(pmax, p1[r]);
  { auto rr = __builtin_amdgcn_permlane32_swap(__float_as_uint(pmax), __float_as_uint(pmax), false, false);
    pmax = fmaxf(__uint_as_float(rr[0]), __uint_as_float(rr[1])); }
  if (__builtin_expect(__all(pmax - m_reg <= THR / SCALE), 1)) { mn = m_reg; alpha = 1.f; }
  else { mn = fmaxf(m_reg, pmax); alpha = __builtin_amdgcn_exp2f((m_reg - mn) * C); m_reg = mn; }
  float mnC = -mn * C;
  for (int r = 0; r < 16; ++r) p0[r] = fmaf(p0[r], C, mnC); for (int r = 0; r < 16; ++r) p1[r] = fmaf(p1[r], C, mnC);
  for (int r = 0; r < 16; ++r) p0[r] = __builtin_amdgcn_exp2f(p0[r]);
}
__device__ __forceinline__ void finishSM(f32x16& p0, f32x16& p1, float alpha, float& l_reg, bf16x8& pa0, bf16x8& pa1, bf16x8& pa2, bf16x8& pa3) {
  for (int r = 0; r < 16; ++r) p1[r] = __builtin_amdgcn_exp2f(p1[r]);
  float ps = 0; for (int r = 0; r < 16; ++r) ps += p0[r]; for (int r = 0; r < 16; ++r) ps += p1[r];
  { auto rr = __builtin_amdgcn_permlane32_swap(__float_as_uint(ps), __float_as_uint(ps), false, false);
    ps = __uint_as_float(rr[0]) + __uint_as_float(rr[1]); }
  l_reg = l_reg * alpha + ps;
#define PK4(P, BASE, OUT) do { unsigned a0 = cvtpk(P[BASE + 0], P[BASE + 1]), a1 = cvtpk(P[BASE + 2], P[BASE + 3]);   \
    unsigned b0 = cvtpk(P[BASE + 4], P[BASE + 5]), b1 = cvtpk(P[BASE + 6], P[BASE + 7]);                              \
    auto r0 = __builtin_amdgcn_permlane32_swap(a0, b0, false, false); auto r1 = __builtin_amdgcn_permlane32_swap(a1, b1, false, false); \
    u32x4 w = {r0[0], r1[0], r0[1], r1[1]}; OUT = *reinterpret_cast<bf16x8*>(&w); } while (0)
  PK4(p0, 0, pa0); PK4(p0, 8, pa1); PK4(p1, 0, pa2); PK4(p1, 8, pa3);
#undef PK4
}
__device__ __forceinline__ void qkt(f32x16& p0, f32x16& p1, const bf16* Ks, const bf16x8* qr, int r32, int hi) {
  p0 = f32x16{}; p1 = f32x16{};
  for (int d0 = 0; d0 < 8; ++d0) { int cb = (d0 * 16 + hi * 8) * 2;
    bf16x8 b0 = *reinterpret_cast<const bf16x8*>((const char*)Ks + KSWZ(r32, cb));
    bf16x8 b1 = *reinterpret_cast<const bf16x8*>((const char*)Ks + KSWZ(32 + r32, cb));
    p0 = __builtin_amdgcn_mfma_f32_32x32x16_bf16(b0, qr[d0], p0, 0, 0, 0);
    p1 = __builtin_amdgcn_mfma_f32_32x32x16_bf16(b1, qr[d0], p1, 0, 0, 0); }
}
__device__ __forceinline__ int v_st(int k, int c) { const int kk = (k & ~0xC) | ((k & 4) << 1) | ((k & 8) >> 1); return ((kk >> 3) * 4 + (c >> 5)) * 512 + ((kk & 7) * 32 + (c & 31)) * 2; }
__device__ __forceinline__ int v_rd_base(int lane) { return ((lane & 3) << 3) | (((lane >> 2) & 3) << 6) | (((lane >> 4) & 1) << 5) | (((lane >> 5) & 1) << 8); }
constexpr int v_rd_off(int d0, int ks, int half) { return d0 * 512 + ks * 4096 + half * 2048; }
template <int OFF> __device__ __forceinline__ s16x4 tr_read(int vb) {
  s16x4 r; asm volatile("ds_read_b64_tr_b16 %0, %1 offset:%2" : "=&v"(r) : "v"(vb), "i"(OFF) : "memory"); return r;
}
template <int D0> __device__ __forceinline__ void pv_one(f32x16& od, int vb, bf16x8 pa0, bf16x8 pa1, bf16x8 pa2, bf16x8 pa3) {
  const s16x4 l0 = tr_read<v_rd_off(D0, 0, 0)>(vb), h0 = tr_read<v_rd_off(D0, 0, 1)>(vb), l1 = tr_read<v_rd_off(D0, 1, 0)>(vb), h1 = tr_read<v_rd_off(D0, 1, 1)>(vb);
  const s16x4 l2 = tr_read<v_rd_off(D0, 2, 0)>(vb), h2 = tr_read<v_rd_off(D0, 2, 1)>(vb), l3 = tr_read<v_rd_off(D0, 3, 0)>(vb), h3 = tr_read<v_rd_off(D0, 3, 1)>(vb);
  asm volatile("s_waitcnt lgkmcnt(0)" ::: "memory"); SBAR();
#define PK(L, H) (bf16x8){L[0], L[1], L[2], L[3], H[0], H[1], H[2], H[3]}
  od = __builtin_amdgcn_mfma_f32_32x32x16_bf16(pa0, PK(l0, h0), od, 0, 0, 0);
  od = __builtin_amdgcn_mfma_f32_32x32x16_bf16(pa1, PK(l1, h1), od, 0, 0, 0);
  od = __builtin_amdgcn_mfma_f32_32x32x16_bf16(pa2, PK(l2, h2), od, 0, 0, 0);
  od = __builtin_amdgcn_mfma_f32_32x32x16_bf16(pa3, PK(l3, h3), od, 0, 0, 0);
#undef PK
}
__device__ __forceinline__ void pv_d0(f32x16* o, int vb, bf16x8 pa0, bf16x8 pa1, bf16x8 pa2, bf16x8 pa3) {
  pv_one<0>(o[0], vb, pa0, pa1, pa2, pa3); pv_one<1>(o[1], vb, pa0, pa1, pa2, pa3); pv_one<2>(o[2], vb, pa0, pa1, pa2, pa3); pv_one<3>(o[3], vb, pa0, pa1, pa2, pa3);
}

template <typename TQ>
__device__ __forceinline__ void attn_dense_body(const TQ* __restrict__ Qb, const bf16* __restrict__ Kh, const bf16* __restrict__ Vh,
                                                bf16* __restrict__ Ob, int seq, char* lds) {
  using St = Stage<bf16>; using SQ = Stage<TQ>;
  int tid_ = threadIdx.x; asm volatile("" : "+v"(tid_));
  const int tid = tid_, wid = tid >> 6, lane = tid & 63, r32 = lane & 31, hi = lane >> 5;
  bf16* V_lds = (bf16*)lds; bf16* K_lds = (bf16*)(lds + 2 * SHM_V);
  float* ws = (float*)(lds + 2 * SHM_V + 2 * SHM_K) + wid * 64; float* li_l = ws; float* al_l = ws + 32;
  float m_reg = -1e30f, l_reg = 0; f32x16 o[4] = {}; bf16x8 qr[8];
  const TQ* Qw = Qb + (long)(wid * QBLK + r32) * LDQ + hi * 8;
#pragma unroll
  for (int d0 = 0; d0 < 8; ++d0) qr[d0] = SQ::tobf(SQ::ld8(Qw + d0 * 16));
  const int sr = tid >> 4, sc = (tid & 15) * 8, vst0 = v_st(sr, sc), vst1 = v_st(32 + sr, sc);
  const int vb0 = (int)(uintptr_t)V_lds + v_rd_base(lane);
  struct { typename St::T vs0, vs1, ks0, ks1; } sr_[SDEPTH];
#define SLOAD(i, k0) do { sr_[i].vs0 = St::ld8(&Vh[(long)((k0) + sr) * LDK + sc]); sr_[i].vs1 = St::ld8(&Vh[(long)((k0) + 32 + sr) * LDK + sc]); \
    sr_[i].ks0 = St::ld8(&Kh[(long)((k0) + sr) * LDK + sc]); sr_[i].ks1 = St::ld8(&Kh[(long)((k0) + 32 + sr) * LDK + sc]); } while (0)
#define SWRITE(b, i) do { *(bf16x8*)((char*)V_lds + (b) * SHM_V + vst0) = St::tobf(sr_[i].vs0);          \
    *(bf16x8*)((char*)V_lds + (b) * SHM_V + vst1) = St::tobf(sr_[i].vs1); int kc = sc * 2;               \
    *(bf16x8*)((char*)K_lds + (b) * SHM_K + KSWZ(sr, kc)) = St::tobf(sr_[i].ks0);                       \
    *(bf16x8*)((char*)K_lds + (b) * SHM_K + KSWZ(32 + sr, kc)) = St::tobf(sr_[i].ks1); } while (0)
#define SWAIT() do { if constexpr (SDEPTH == 2) asm volatile("s_waitcnt vmcnt(4)" ::: "memory"); else asm volatile("s_waitcnt vmcnt(0)" ::: "memory"); } while (0)
#define RESC(a) do { if (__any((a) < 1.f)) { if (hi == 0) al_l[r32] = (a); asm volatile("s_waitcnt lgkmcnt(0)" ::: "memory"); \
    for (int d = 0; d < 4; ++d) for (int r = 0; r < 16; ++r) o[d][r] *= al_l[crow(r, hi)]; } } while (0)
  f32x16 pA0, pA1, pB0, pB1; float mnA, mnB, alA, alB; bf16x8 pa0, pa1, pa2, pa3; const int NT = seq / KVBLK;
  constexpr int SE = 0, SO = SDEPTH - 1;
  SLOAD(SE, 0); asm volatile("s_waitcnt vmcnt(0)" ::: "memory"); SWRITE(0, SE); __syncthreads();
  qkt(pA0, pA1, K_lds, qr, r32, hi); partialSM(pA0, pA1, m_reg, mnA, alA);
  SLOAD(SO, KVBLK); if constexpr (SDEPTH == 2) { if (2 < NT) SLOAD(SE, 2 * KVBLK); }
  SWAIT(); SWRITE(1, SO); __syncthreads();
  for (int j = 1; j + 1 < NT; j += 2) {
    SBAR(); qkt(pB0, pB1, (bf16*)((char*)K_lds + SHM_K), qr, r32, hi);
    finishSM(pA0, pA1, alA, l_reg, pa0, pa1, pa2, pa3); SBAR();
    SLOAD(SO, (j + SDEPTH) * KVBLK); SBAR();
    pv_d0(o, vb0, pa0, pa1, pa2, pa3); partialSM(pB0, pB1, m_reg, mnB, alB);
    __syncthreads(); SWAIT(); SWRITE(0, SE);
    RESC(alB); __syncthreads();
    SBAR(); qkt(pA0, pA1, K_lds, qr, r32, hi);
    finishSM(pB0, pB1, alB, l_reg, pa0, pa1, pa2, pa3); SBAR();
    if (SDEPTH == 1 || j + 3 < NT) SLOAD(SE, (j + 1 + SDEPTH) * KVBLK); SBAR();
    pv_d0(o, vb0 + (int)SHM_V, pa0, pa1, pa2, pa3); partialSM(pA0, pA1, m_reg, mnA, alA);
    __syncthreads(); SWAIT(); SWRITE(1, SO);
    RESC(alA); __syncthreads();
  }
  SBAR(); qkt(pB0, pB1, (bf16*)((char*)K_lds + SHM_K), qr, r32, hi);
  finishSM(pA0, pA1, alA, l_reg, pa0, pa1, pa2, pa3); SBAR();
  pv_d0(o, vb0, pa0, pa1, pa2, pa3); partialSM(pB0, pB1, m_reg, mnB, alB);
  __syncthreads(); RESC(alB);
  finishSM(pB0, pB1, alB, l_reg, pa0, pa1, pa2, pa3); SBAR();
  pv_d0(o, vb0 + (int)SHM_V, pa0, pa1, pa2, pa3);
  if (hi == 0) li_l[r32] = l_reg; asm volatile("s_waitcnt lgkmcnt(0)" ::: "memory");
  float rli[16];
#pragma unroll
  for (int r = 0; r < 16; ++r) rli[r] = __builtin_amdgcn_rcpf(li_l[crow(r, hi)]);
  bf16* Ow = Ob + (long)(wid * QBLK) * LDO;
#pragma unroll
  for (int r = 0; r < 16; ++r) { int orow = crow(r, hi);
    for (int d0 = 0; d0 < 4; ++d0) Ow[(long)orow * LDO + d0 * 32 + r32] = __float2bfloat16(o[d0][r] * rli[r]); }
#undef SLOAD
#undef SWRITE
#undef SWAIT
#undef RESC
}

template <int D0> __device__ __forceinline__ void pv_ld(s16x4 (&t)[8], int vb) {
  t[0] = tr_read<v_rd_off(D0, 0, 0)>(vb); t[1] = tr_read<v_rd_off(D0, 0, 1)>(vb); t[2] = tr_read<v_rd_off(D0, 1, 0)>(vb); t[3] = tr_read<v_rd_off(D0, 1, 1)>(vb);
  t[4] = tr_read<v_rd_off(D0, 2, 0)>(vb); t[5] = tr_read<v_rd_off(D0, 2, 1)>(vb); t[6] = tr_read<v_rd_off(D0, 3, 0)>(vb); t[7] = tr_read<v_rd_off(D0, 3, 1)>(vb);
}
__device__ __forceinline__ void pv_mm(f32x16& od, const s16x4 (&t)[8], bf16x8 pa0, bf16x8 pa1, bf16x8 pa2, bf16x8 pa3) {
#define PK(L, H) (bf16x8){L[0], L[1], L[2], L[3], H[0], H[1], H[2], H[3]}
  od = __builtin_amdgcn_mfma_f32_32x32x16_bf16(pa0, PK(t[0], t[1]), od, 0, 0, 0);
  od = __builtin_amdgcn_mfma_f32_32x32x16_bf16(pa1, PK(t[2], t[3]), od, 0, 0, 0);
  od = __builtin_amdgcn_mfma_f32_32x32x16_bf16(pa2, PK(t[4], t[5]), od, 0, 0, 0);
  od = __builtin_amdgcn_mfma_f32_32x32x16_bf16(pa3, PK(t[6], t[7]), od, 0, 0, 0);
#undef PK
}
#define PV_WAIT8() do { asm volatile("s_waitcnt lgkmcnt(8)" ::: "memory"); SBAR(); } while (0)
__device__ __forceinline__ void pv8(f32x16* o, int vb, bf16x8 pa0, bf16x8 pa1, bf16x8 pa2, bf16x8 pa3) {
  s16x4 A[8], B[8]; const int vb2 = vb + 16384;
  pv_ld<0>(A, vb);
  pv_ld<1>(B, vb);  PV_WAIT8(); pv_mm(o[0], A, pa0, pa1, pa2, pa3);
  pv_ld<2>(A, vb);  PV_WAIT8(); pv_mm(o[1], B, pa0, pa1, pa2, pa3);
  pv_ld<3>(B, vb);  PV_WAIT8(); pv_mm(o[2], A, pa0, pa1, pa2, pa3);
  pv_ld<0>(A, vb2); PV_WAIT8(); pv_mm(o[3], B, pa0, pa1, pa2, pa3);
  pv_ld<1>(B, vb2); PV_WAIT8(); pv_mm(o[4], A, pa0, pa1, pa2, pa3);
  pv_ld<2>(A, vb2); PV_WAIT8(); pv_mm(o[5], B, pa0, pa1, pa2, pa3);
  pv_ld<3>(B, vb2); PV_WAIT8(); pv_mm(o[6], A, pa0, pa1, pa2, pa3);
  asm volatile("s_waitcnt lgkmcnt(0)" ::: "memory"); SBAR(); pv_mm(o[7], B, pa0, pa1, pa2, pa3);
}
#undef PV_WAIT8
constexpr int A256_V = 0, A256_K = 65536, A256_Q = 98304, A256_WS = 131072, A256_LDS = 133120;
__device__ __forceinline__ void attn256_body(const bf16* __restrict__ Qb, const bf16* __restrict__ Kh, const bf16* __restrict__ Vh, bf16* __restrict__ Ob, int seq, char* lds) {
  int tid_ = threadIdx.x; asm volatile("" : "+v"(tid_));
  const int tid = tid_, wid = __builtin_amdgcn_readfirstlane(tid >> 6), lane = tid & 63, r32 = lane & 31, hi = lane >> 5;
  typedef __attribute__((address_space(3))) unsigned lds_u32;
  char* Q_lds = lds + A256_Q + (wid * 4 * 64 + lane) * 16;
  float* ws = (float*)(lds + A256_WS) + wid * 64; float* li_l = ws; float* al_l = ws + 32;
  float m_reg = -1e30f, l_reg = 0; f32x16 o[8] = {}; bf16x8 qr[4];
  { const bf16* Qw = Qb + (long)(wid * QBLK + r32) * LDQ + hi * 8;
#pragma unroll
    for (int d0 = 0; d0 < 4; ++d0) qr[d0] = *reinterpret_cast<const bf16x8*>(Qw + d0 * 16);
#pragma unroll
    for (int d0 = 4; d0 < 8; ++d0) *(bf16x8*)(Q_lds + (d0 - 4) * 1024) = *reinterpret_cast<const bf16x8*>(Qw + d0 * 16); }
  int offk[2], offv[2];
#pragma unroll
  for (int i = 0; i < 2; ++i) { const int s = tid + 512 * i;
    { const int row = s >> 4, cs = s & 15; offk[i] = row * LDK + ((cs ^ (row & 7)) << 3); }
    { const int sub = s >> 5, rowk = (s >> 2) & 7, cc = s & 3, kk = (sub >> 2) * 8 + rowk, key = (kk & ~0xC) | ((kk & 4) << 1) | ((kk & 8) >> 1);
      offv[i] = key * LDK + (sub & 3) * 32 + cc * 8; } }
  const int ldsw = wid * 1024;
#define A256_DMA(k0, buf) do { const bf16* kt = Kh + (long)(k0) * LDK; const bf16* vt = Vh + (long)(k0) * LDK; \
    _Pragma("unroll") for (int i = 0; i < 2; ++i) { \
      __builtin_amdgcn_global_load_lds((const unsigned*)(kt + offk[i]), (lds_u32*)(lds + A256_K + (buf) * 16384 + ldsw + i * 8192), 16, 0, 0); \
      __builtin_amdgcn_global_load_lds((const unsigned*)(vt + offv[i]), (lds_u32*)(lds + A256_V + (buf) * 32768 + ldsw + i * 8192), 16, 0, 0); \
      __builtin_amdgcn_global_load_lds((const unsigned*)(vt + 128 + offv[i]), (lds_u32*)(lds + A256_V + (buf) * 32768 + 16384 + ldsw + i * 8192), 16, 0, 0); } } while (0)
#define A256_RESC(a) do { if (__any((a) < 1.f)) { if (hi == 0) al_l[r32] = (a); asm volatile("s_waitcnt lgkmcnt(0)" ::: "memory"); \
    for (int d = 0; d < 8; ++d) for (int r = 0; r < 16; ++r) o[d][r] *= al_l[crow(r, hi)]; } } while (0)
  const int vb0 = (int)(uintptr_t)(lds + A256_V) + v_rd_base(lane);
  f32x16 p0, p1; float mn, al; bf16x8 pa0, pa1, pa2, pa3; const int NT = seq / KVBLK;
  A256_DMA(0, 0);
  asm volatile("s_waitcnt vmcnt(0) lgkmcnt(0)" ::: "memory"); __builtin_amdgcn_s_barrier(); asm volatile("" ::: "memory");
  if (wid >= 4) __builtin_amdgcn_s_setprio(1);
  for (int j = 0; j < NT; ++j) {
    if (j + 1 < NT) A256_DMA((j + 1) * KVBLK, (j + 1) & 1);
    SBAR();
    const char* K_lds = lds + A256_K + (j & 1) * 16384;
    p0 = f32x16{}; p1 = f32x16{};
#pragma unroll
    for (int d0 = 0; d0 < 8; ++d0) { const int cb = (d0 * 16 + hi * 8) * 2;
      const bf16x8 b0 = *reinterpret_cast<const bf16x8*>(K_lds + KSWZ(r32, cb)), b1 = *reinterpret_cast<const bf16x8*>(K_lds + KSWZ(32 + r32, cb));
      const bf16x8 q = d0 < 4 ? qr[d0 & 3] : *reinterpret_cast<const bf16x8*>(Q_lds + (d0 - 4) * 1024);
      p0 = __builtin_amdgcn_mfma_f32_32x32x16_bf16(b0, q, p0, 0, 0, 0); p1 = __builtin_amdgcn_mfma_f32_32x32x16_bf16(b1, q, p1, 0, 0, 0); }
    SBAR();
    partialSM(p0, p1, m_reg, mn, al);
    A256_RESC(al);
    finishSM(p0, p1, al, l_reg, pa0, pa1, pa2, pa3); SBAR();
    pv8(o, vb0 + (j & 1) * 32768, pa0, pa1, pa2, pa3);
    asm volatile("s_waitcnt vmcnt(0) lgkmcnt(0)" ::: "memory"); __builtin_amdgcn_s_barrier(); asm volatile("" ::: "memory");
  }
  __builtin_amdgcn_s_setprio(0);
  if (hi == 0) li_l[r32] = l_reg; asm volatile("s_waitcnt lgkmcnt(0)" ::: "memory");
  float rli[16];
#pragma unroll
  for (int r = 0; r < 16; ++r) rli[r] = __builtin_amdgcn_rcpf(li_l[crow(r, hi)]);
  bf16* Ow = Ob + (long)(wid * QBLK) * LDO;
#pragma unroll
  for (int r = 0; r < 16; ++r) { const int orow = crow(r, hi);
#pragma unroll
    for (int d0 = 0; d0 < 8; ++d0) Ow[(long)orow * LDO + d0 * 32 + r32] = __float2bfloat16(o[d0][r] * rli[r]); }
#undef A256_DMA
#undef A256_RESC
}
}
#ifndef MK_PER_PHASE
#define MK_PER_PHASE 0
#endif
constexpr int NWAVES = 8;
constexpr int M = 8192, SEQ = 4096, DM = 4096, FF = 3072, NP = 26624, NL = 4;
constexpr float EPS = 1e-6f;
constexpr int P_AQ = 0, P_AK = 2048, P_AV = 4096, P_GQ = 6144, P_GK = 6656, P_GV = 7168, P_GR = 8192, P_HQ = 9216, P_HZF = 10240, P_HZB = 11264, P_HI = 12288, P_HG = 13312,
              P_GA = 14336, P_GG = 18432, P_GH = 22528;
constexpr size_t MiB = 1u << 20;
constexpr size_t WS_CTL = 0, CTL_ZERO_BYTES = 2 * MiB;
constexpr size_t WS_TAB = 2 * MiB;
constexpr size_t WS_ROPE = 3 * MiB;
constexpr size_t WS_W = 5 * MiB;
constexpr size_t OW_1A = 0, OW_1B = OW_1A + (size_t)6144 * 4096, OW_IN = OW_1B + (size_t)4096 * 3072, OW_A = OW_IN + (size_t)NP * 4096, OW_B = OW_A + (size_t)4096 * 2048,
                 OW_C = OW_B + (size_t)4096 * 1024, OW_O = OW_C + (size_t)4096 * 1024, OW_2A = OW_O + (size_t)4096 * 4096, OW_2B = OW_2A + (size_t)6144 * 4096, LAYER_W = OW_2B + (size_t)4096 * 3072;
constexpr size_t WS_H = WS_W + ((NL * LAYER_W * 2 + MiB - 1) / MiB) * MiB;
constexpr size_t WS_ACT = WS_H + (size_t)M * DM * 2;
constexpr size_t WS_P = WS_ACT + (size_t)M * FF * 2;
constexpr size_t WS_QN = WS_P + (size_t)M * NP * 2;
constexpr size_t WS_KN = WS_QN + (size_t)M * 2048 * 2;
constexpr size_t WS_VN = WS_KN + (size_t)M * 2048 * 2;
constexpr size_t WS_GF = WS_VN + (size_t)M * 2048 * 2;
constexpr size_t WS_HF = WS_GF + (size_t)2 * M * 512 * 4;
constexpr size_t WS_O12 = WS_HF + (size_t)2 * M * 1024 * 4;
constexpr size_t WS_OSG = WS_O12 + (size_t)2 * M * 2048 * 4;
constexpr size_t WS_OSH = WS_OSG + (size_t)2 * M * 1024 * 4;
constexpr size_t WS_OA = WS_OSH + (size_t)2 * M * 1024 * 4;
constexpr size_t WS_OG = WS_OA + (size_t)M * 2048 * 2;
constexpr size_t WS_OH = WS_OG + (size_t)M * 1024 * 2;
constexpr size_t WS_M32 = WS_OH + (size_t)M * 1024 * 2;
constexpr size_t WS_MB = WS_M32 + (size_t)M * DM * 4;
constexpr size_t WS_WLR = WS_MB + (size_t)M * DM * 2;
constexpr size_t WS_END = WS_WLR + (size_t)NL * 32 * 4096 * 2;
constexpr size_t WS_X8 = WS_M32;
constexpr int G8_D0 = P_GA / 32;
constexpr size_t OW8_OFF = (size_t)P_GA * 4096;
constexpr int CW_TMO = 0, CW_BAR = 4096;
constexpr size_t WS_SS = 1 * MiB;
static_assert(WS_SS + (size_t)(1 + 3 * NL) * M * 8 <= CTL_ZERO_BYTES, "SS inside the memset region");
constexpr int RING_OFF = 0, RING_BYTES = 151552;
constexpr int LDSCTL_OFF = RING_BYTES, MISC_OFF = LDSCTL_OFF + 320;
constexpr int LDS_BYTES = 163840;
static_assert(att::A256_LDS <= RING_BYTES && MISC_OFF + 128 <= LDS_BYTES, "LDS map");

#define GAS __attribute__((address_space(1)))
#define LAS __attribute__((address_space(3)))
typedef unsigned short bf16;
typedef unsigned v4u __attribute__((ext_vector_type(4)));
typedef unsigned v2u __attribute__((ext_vector_type(2)));
typedef float f32x4 __attribute__((ext_vector_type(4)));
typedef float f32x2 __attribute__((ext_vector_type(2)));
typedef GAS unsigned gu32;
#define RLX_AGENT __ATOMIC_RELAXED, __HIP_MEMORY_SCOPE_AGENT
#define LDS_WAIT() asm volatile("s_waitcnt lgkmcnt(0)" ::: "memory")
#define VM_WAIT() asm volatile("s_waitcnt vmcnt(0)" ::: "memory")
typedef __bf16 bf16x2_t __attribute__((ext_vector_type(2)));
__device__ __forceinline__ unsigned pk2(float lo, float hi) { const f32x2 v = {lo, hi}; return __builtin_bit_cast(unsigned, __builtin_convertvector(v, bf16x2_t)); }
__device__ __forceinline__ float bflo(unsigned w) { return __uint_as_float(w << 16); }
__device__ __forceinline__ float bfhi(unsigned w) { return __uint_as_float(w & 0xffff0000u); }
__device__ __forceinline__ float bf1(bf16 h) { return __uint_as_float(((unsigned)h) << 16); }
__device__ __forceinline__ float sigm(float x) { return __builtin_amdgcn_rcpf(1.0f + __builtin_amdgcn_exp2f(-1.4426950408889634f * x)); }

#define XB_TMO      128
#define XB_XCNT(j)  (256  + 64 * (j))
#define XB_XSUB(j)  (1280 + 64 * (j))
#define XB_XGEN(j)  (2304 + 64 * (j))
#define XB_TOP      3328
#define XB_TOPGEN   3392
#define XCD_BAR_WORDS 3456
#define XB_SPIN_CAP (1u << 18)

__device__ __forceinline__ unsigned xb_ld(unsigned* p)              { return __hip_atomic_load(p, __ATOMIC_RELAXED, __HIP_MEMORY_SCOPE_AGENT); }
__device__ __forceinline__ unsigned xb_add(unsigned* p, unsigned v) { return __hip_atomic_fetch_add(p, v, __ATOMIC_RELAXED, __HIP_MEMORY_SCOPE_AGENT); }
__device__ __forceinline__ unsigned xb_xcc_id() { return (unsigned)__builtin_amdgcn_s_getreg((3 << 11) | 20) & 0xFu; }
#define XB_SPIN(cond, bar) do { unsigned _sp = 0; while (cond) { __builtin_amdgcn_s_sleep(1); \
    if ((++_sp & 255u) == 0u) { if (xb_ld(&(bar)[XB_TMO])) break; if (_sp > XB_SPIN_CAP) { atomicAdd(&(bar)[XB_TMO], 1u); break; } } } } while (0)

struct XcdBarrier {
    unsigned* bar; unsigned x;
    volatile LAS unsigned* st;
};

__device__ __forceinline__ XcdBarrier xcd_barrier_post(unsigned* bar, volatile LAS unsigned* st) {
    XcdBarrier b; b.bar = bar; b.x = xb_xcc_id(); b.st = st;
    if (threadIdx.x == 0) (void)xb_add(&bar[XB_XCNT(b.x)], 1u);
    return b;
}
__device__ __forceinline__ void xcd_barrier_complete(unsigned* bar, unsigned x, unsigned& nloc, unsigned& nx) {
    const unsigned G = gridDim.x * gridDim.y * gridDim.z;
    unsigned sum, cnt, mine, sp = 0u;
    for (;;) {
        sum = 0u; cnt = 0u; mine = 0u;
#pragma unroll
        for (unsigned j = 0; j < 16; ++j) { const unsigned c = xb_ld(&bar[XB_XCNT(j)]); sum += c; cnt += (c > 0u) ? 1u : 0u; mine = (j == x) ? c : mine; }
        if (sum == G) break;
        __builtin_amdgcn_s_sleep(1);
        if ((++sp & 255u) == 0u) { if (xb_ld(&bar[XB_TMO])) break; if (sp > XB_SPIN_CAP) { atomicAdd(&bar[XB_TMO], 1u); break; } }
    }
    nloc = mine > 0u ? mine : 1u; nx = cnt > 0u ? cnt : 1u;
}

__device__ __forceinline__ void xcd_barrier(const XcdBarrier& b) {
    asm volatile("s_waitcnt vmcnt(0)" ::: "memory");
    __syncthreads();
    if (threadIdx.x == 0) {
        unsigned* bar = b.bar;
        __builtin_amdgcn_s_waitcnt(0);
        unsigned nloc = b.st[0], nx = b.st[1];
        if (nloc == 0u) { xcd_barrier_complete(bar, b.x, nloc, nx); b.st[0] = nloc; b.st[1] = nx; }
        const unsigned old = xb_add(&bar[XB_XSUB(b.x)], 1u);
        const unsigned gen = old / nloc;
        if (old + 1u == (gen + 1u) * nloc) {
            __builtin_amdgcn_fence(__ATOMIC_RELEASE, "agent");
            asm volatile("s_waitcnt vmcnt(0)" ::: "memory");
            const unsigned og = xb_add(&bar[XB_TOP], 1u);
            const unsigned tg = og / nx;
            if (og + 1u == (tg + 1u) * nx) xb_add(&bar[XB_TOPGEN], 1u);
            else XB_SPIN(xb_ld(&bar[XB_TOPGEN]) == tg, bar);
            __builtin_amdgcn_fence(__ATOMIC_ACQUIRE, "agent");
            xb_add(&bar[XB_XGEN(b.x)], 1u);
            asm volatile("s_waitcnt vmcnt(0)" ::: "memory");
        } else {
            XB_SPIN(xb_ld(&bar[XB_XGEN(b.x)]) == gen, bar);
            __builtin_amdgcn_fence(__ATOMIC_ACQUIRE, "agent");
            asm volatile("s_waitcnt vmcnt(0)" ::: "memory");
        }
    }
    __syncthreads();
}

struct Ctx {
    LAS unsigned char* lds;
    int wave, G, vcu, gw, ngw;
    const float* const* in; float* out; unsigned char* ws;
};
__device__ __forceinline__ int opaque_tid() { int t = threadIdx.x; asm volatile("" : "+v"(t)); return t; }
__device__ __forceinline__ int opaque_gw(const Ctx& C) { int g = C.gw; asm volatile("" : "+s"(g)); return g; }
__device__ __forceinline__ unsigned char* opaque_ws(const Ctx& C) { unsigned z = 0u; asm volatile("" : "+s"(z)); return C.ws + z; }
__device__ __forceinline__ float wave_sum(float v) {
#pragma unroll
    for (int o = 1; o < 64; o <<= 1) v += __shfl_xor(v, o);
    return v;
}
__device__ __forceinline__ float half_sum32(float v) {
#pragma unroll
    for (int o = 1; o < 32; o <<= 1) v += __shfl_xor(v, o);
    return v;
}

constexpr float W8_SCALE = 256.0f;
template <bool F8 = false> __device__ __forceinline__ void tr_item(const float* W, int ldw, int srccol, bf16* WT, int K, int dstrow, int kb, LAS float* scr, int lane, const float* gain = nullptr, int kdst = 0) {
    const int k0 = 64 * kb;
    if (srccol < 0) {
        const int n = lane & 31, cp = lane >> 5;
#pragma unroll
        for (int j = 0; j < 4; ++j) *(GAS v4u*)(WT + (size_t)(dstrow + n) * K + kdst + k0 + 8 * (cp + 2 * j)) = (v4u){0u, 0u, 0u, 0u};
        return;
    }
    const int rr = lane >> 3, cq = lane & 7;
    f32x4 v[8];
    const float* src = W + (size_t)(k0 + rr) * ldw + srccol + 4 * cq;
#pragma unroll
    for (int i = 0; i < 8; ++i) v[i] = __builtin_nontemporal_load((const GAS f32x4*)(src + (size_t)(8 * i) * ldw));
    if (gain) {
#pragma unroll
        for (int i = 0; i < 8; ++i) v[i] = v[i] * gain[k0 + 8 * i + rr];
    }
#pragma unroll
    for (int i = 0; i < 8; ++i) {
#pragma unroll
        for (int e = 0; e < 4; ++e) scr[(4 * cq + e) * 65 + 8 * i + rr] = v[i][e];
    }
    LDS_WAIT(); asm volatile("" ::: "memory");
    const int n = lane & 31, cp = lane >> 5;
#pragma unroll
    for (int j = 0; j < 4; ++j) { const int c = cp + 2 * j; const LAS float* s = scr + n * 65 + 8 * c;
        if (F8) { int lo = __builtin_amdgcn_cvt_pk_fp8_f32(s[0] * W8_SCALE, s[1] * W8_SCALE, 0, false); lo = __builtin_amdgcn_cvt_pk_fp8_f32(s[2] * W8_SCALE, s[3] * W8_SCALE, lo, true);
            int hi = __builtin_amdgcn_cvt_pk_fp8_f32(s[4] * W8_SCALE, s[5] * W8_SCALE, 0, false); hi = __builtin_amdgcn_cvt_pk_fp8_f32(s[6] * W8_SCALE, s[7] * W8_SCALE, hi, true);
            *(GAS v2u*)((unsigned char*)WT + (size_t)(dstrow + n) * K + kdst + k0 + 8 * c) = (v2u){(unsigned)lo, (unsigned)hi}; }
        else { v4u o; o.x = pk2(s[0], s[1]); o.y = pk2(s[2], s[3]); o.z = pk2(s[4], s[5]); o.w = pk2(s[6], s[7]);
            *(GAS v4u*)(WT + (size_t)(dstrow + n) * K + kdst + k0 + 8 * c) = o; } }
    LDS_WAIT(); asm volatile("" ::: "memory");
}
constexpr int I_1A = 64 * 192, I_1B = 48 * 128, I_IN = 64 * 832, I_LR = 64, I_A = 32 * 128, I_B = 16 * 128, I_C = 16 * 128, I_O = 64 * 128;
constexpr int I_LAYER = I_1A + I_1B + I_IN + I_LR + I_A + I_B + I_C + I_O + I_1A + I_1B, I_EARLY = I_1A + I_1B + I_IN + I_LR, I_LATE = I_LAYER - I_EARLY;
__device__ __forceinline__ void conv_item(Ctx& C, unsigned char* ws, int l, int r, LAS float* scr, int lane) {
    bf16* wl = (bf16*)(ws + WS_W) + (size_t)l * LAYER_W;
        if (r < I_1A) { const float* W = C.in[2] + (size_t)l * 4096 * 6144; const int kb = r / 192, d = r % 192, pn = d >> 3, bj = (d >> 2) & 1, q = d & 3;
            tr_item(W, 6144, bj * 3072 + pn * 128 + q * 32, wl + OW_1A, 4096, d * 32, kb, scr, lane, C.in[1] + l * DM); return; }
        r -= I_1A;
        if (r < I_1B) { const float* W = C.in[3] + (size_t)l * 3072 * 4096; const int kb = r / 128, d = r % 128;
            tr_item(W, 4096, d * 32, wl + OW_1B, 3072, d * 32, kb, scr, lane); return; }
        r -= I_1B;
        if (r < I_IN) { const float* W = C.in[5] + (size_t)l * 4096 * 26656; const int kb = r / 832, d = r % 832;
            if (d < G8_D0) tr_item(W, 26656, (d < 288 ? d : d + 1) * 32, wl + OW_IN, 4096, d * 32, kb, scr, lane, C.in[4] + l * DM);
            else tr_item<true>(W, 26656, (d + 1) * 32, wl + OW_IN + OW8_OFF, 4096, (d - G8_D0) * 32, kb, scr, lane, C.in[4] + l * DM);
            return; }
        r -= I_IN;
        if (r < I_LR) { const float* W = C.in[5] + (size_t)l * 4096 * 26656;
            tr_item(W, 26656, 9216, (bf16*)(ws + WS_WLR) + (size_t)l * 32 * 4096, 4096, 0, r, scr, lane, C.in[4] + l * DM); return; }
        r -= I_LR;
        if (r < I_A) { const float* W = C.in[18] + (size_t)l * 2048 * 4096; const int kb = r / 128, d = r % 128;
            tr_item(W, 4096, d * 32, wl + OW_A, 4096, d * 32, kb, scr, lane, nullptr, 0); return; }
        r -= I_A;
        if (r < I_B) { const float* W = C.in[19] + (size_t)l * 1024 * 4096; const int kb = r / 128, d = r % 128;
            tr_item(W, 4096, d * 32, wl + OW_A, 4096, d * 32, kb, scr, lane, nullptr, 2048); return; }
        r -= I_B;
        if (r < I_C) { const float* W = C.in[20] + (size_t)l * 1024 * 4096; const int kb = r / 128, d = r % 128;
            tr_item(W, 4096, d * 32, wl + OW_A, 4096, d * 32, kb, scr, lane, nullptr, 3072); return; }
        r -= I_C;
        if (r < I_O) { const float* W = C.in[21] + (size_t)l * 4096 * 4096; const int kb = r / 128, d = r % 128;
            tr_item(W, 4096, d * 32, wl + OW_O, 4096, d * 32, kb, scr, lane); return; }
        r -= I_O;
        if (r < I_1A) { const float* W = C.in[23] + (size_t)l * 4096 * 6144; const int kb = r / 192, d = r % 192, pn = d >> 3, bj = (d >> 2) & 1, q = d & 3;
            tr_item(W, 6144, bj * 3072 + pn * 128 + q * 32, wl + OW_2A, 4096, d * 32, kb, scr, lane, C.in[22] + l * DM); return; }
        r -= I_1A;
        { const float* W = C.in[24] + (size_t)l * 3072 * 4096; const int kb = r / 128, d = r % 128;
            tr_item(W, 4096, d * 32, wl + OW_2B, 3072, d * 32, kb, scr, lane); }
}
__device__ __forceinline__ void prologue(Ctx& C) {
    const int lane = opaque_tid() & 63; unsigned char* ws = opaque_ws(C);
    LAS float* scr = (LAS float*)(C.lds + RING_OFF + C.wave * 8448);
    for (int it = C.gw; it < I_EARLY; it += C.ngw) conv_item(C, ws, 0, it, scr, lane);
    { bf16* XB = (bf16*)(ws + WS_H); unsigned long long* SS0 = (unsigned long long*)(ws + WS_SS); const float* x = C.in[0];
      for (int m = C.gw; m < M; m += C.ngw) { const GAS f32x4* xr = (const GAS f32x4*)(x + (size_t)m * DM) + lane; GAS v2u* o = (GAS v2u*)(XB + (size_t)m * DM) + lane; float q = 0.f;
#pragma unroll
        for (int j = 0; j < 16; ++j) { const f32x4 v = xr[64 * j]; q += (v.x * v.x + v.y * v.y) + (v.z * v.z + v.w * v.w); o[64 * j] = (v2u){pk2(v.x, v.y), pk2(v.z, v.w)}; }
        q = wave_sum(q); if (lane == 0) SS0[m] = (unsigned long long)(q * 1048576.0f + 0.5f); } }
    f32x2* rope = (f32x2*)(ws + WS_ROPE);
    for (int e = C.gw * 64 + lane; e < SEQ * 64; e += C.ngw * 64) {
        const int pos = e >> 6, i = e & 63;
        const float inv = powf(10000.0f, -(float)i * (1.0f / 64.0f));
        const float ang = (float)pos * inv;
        float s, c; sincosf(ang, &s, &c);
        rope[e] = (f32x2){c, s};
    }
    float* LB = (float*)(ws + WS_TAB);
    for (int e = C.gw * 64 + lane; e < 2 * 1024; e += C.ngw * 64) {
        const int dir = e >> 10, c = e & 1023; const float* lg = dir ? C.in[16] : C.in[15];
        float z[NL], mx = -1e30f;
#pragma unroll
        for (int l = 0; l < NL; ++l) { z[l] = lg[l * 1024 + c]; mx = fmaxf(mx, z[l]); }
        float sum = 0.f;
#pragma unroll
        for (int l = 0; l < NL; ++l) { z[l] = expf(z[l] - mx); sum += z[l]; }
        const float p0 = z[0] / sum; float cum = 0.f;
#pragma unroll
        for (int l = 0; l < NL; ++l) { cum += z[l] / sum; const float lb = fminf(fmaxf(cum - p0, 0.0f), 1.0f - 1e-6f); LB[(dir * NL + l) * 1024 + c] = lb; }
    }
    if (C.gw < NL) {
        const int l = C.gw; const float* lv = C.in[8] + (size_t)l * 4 * 128;
        float a = lv[lane] * lv[128 + lane] + lv[64 + lane] * lv[128 + 64 + lane];
        float b = lv[256 + lane] * lv[384 + lane] + lv[256 + 64 + lane] * lv[384 + 64 + lane];
        a = wave_sum(a); b = wave_sum(b);
        const float lam_init = 0.8f - 0.6f * expf(-0.3f * (float)l);
        if (lane == 0) { float* LAM = (float*)(ws + WS_TAB + 65536); LAM[2 * l] = expf(a) - expf(b) + lam_init; LAM[2 * l + 1] = 1.0f - lam_init; }
    }
}

typedef short sbf16x8 __attribute__((ext_vector_type(8)));
#define MFMA16(Pf, Qf, ACC) __builtin_amdgcn_mfma_f32_16x16x32_bf16((Pf), (Qf), (ACC), 0, 0, 0)
__device__ __forceinline__ float row16_sum(float v) {
#pragma unroll
    for (int o = 1; o < 16; o <<= 1) v += __shfl_xor(v, o);
    return v;
}
__device__ __forceinline__ void prep_phase(Ctx& C, int l) {
    const int tid = opaque_tid(), lane = tid & 63; unsigned char* ws = opaque_ws(C);
    const bf16* P = (const bf16*)(ws + WS_P);
    bf16* QN = (bf16*)(ws + WS_QN); bf16* KN = (bf16*)(ws + WS_KN);
    float* GF = (float*)(ws + WS_GF); float* HF = (float*)(ws + WS_HF);
    const float* LB = (const float*)(ws + WS_TAB);
    const f32x4* rope = (const f32x4*)(ws + WS_ROPE);
    const int g4 = lane >> 4, j = lane & 15;
    LAS float* LW = (LAS float*)(C.lds + RING_OFF);
    { const float* w2f = C.in[10] + (size_t)l * 16 * 512; const float* w2b = C.in[12] + (size_t)l * 16 * 512; const float* bf_ = C.in[11] + (size_t)l * 512; const float* bb_ = C.in[13] + (size_t)l * 512;
      for (int i = tid; i < 2048; i += NWAVES * 64) { *(LAS f32x4*)(LW + 4 * i) = *(const GAS f32x4*)(w2f + 4 * i); *(LAS f32x4*)(LW + 8192 + 4 * i) = *(const GAS f32x4*)(w2b + 4 * i); }
      if (tid < 128) *(LAS f32x4*)(LW + 16384 + 4 * tid) = *(const GAS f32x4*)(bf_ + 4 * tid); else if (tid < 256) *(LAS f32x4*)(LW + 16384 + 512 + 4 * (tid - 128)) = *(const GAS f32x4*)(bb_ + 4 * (tid - 128));
      LDS_WAIT(); __syncthreads(); }
    const float* qg = C.in[6] + l * 128; const float* kg = C.in[7] + l * 128;
    const f32x4 gq0 = *(const GAS f32x4*)(qg + 4 * j), gq1 = *(const GAS f32x4*)(qg + 64 + 4 * j), gk0 = *(const GAS f32x4*)(kg + 4 * j), gk1 = *(const GAS f32x4*)(kg + 64 + 4 * j);
    const bf16* XB = (const bf16*)(ws + WS_H); const bf16* WLR = (const bf16*)(ws + WS_WLR) + (size_t)l * 32 * 4096;
    const unsigned long long* SSm = (const unsigned long long*)(ws + WS_SS) + (size_t)(3 * l + 1) * M;
    LAS float* PB = (LAS float*)(C.lds + RING_OFF + 72 * 1024);
    LAS float* LR = (LAS float*)(C.lds + RING_OFF + 104 * 1024);
    for (int tb = C.vcu; tb < M / 32; tb += C.G) {
    {
        const int r = lane & 15, g = lane >> 4;
        f32x4 acc00 = {0.f, 0.f, 0.f, 0.f}, acc01 = acc00, acc10 = acc00, acc11 = acc00;
        const bf16* xa = XB + (size_t)(32 * tb + r) * DM + 512 * C.wave + 8 * g; const bf16* wb = WLR + (size_t)r * 4096 + 512 * C.wave + 8 * g;
#pragma unroll 4
        for (int ks = 0; ks < 16; ++ks) {
            const sbf16x8 a0 = *(const GAS sbf16x8*)(xa + 32 * ks), a1 = *(const GAS sbf16x8*)(xa + 16 * DM + 32 * ks);
            const sbf16x8 b0 = *(const GAS sbf16x8*)(wb + 32 * ks), b1 = *(const GAS sbf16x8*)(wb + 16 * 4096 + 32 * ks);
            acc00 = MFMA16(a0, b0, acc00); acc01 = MFMA16(a0, b1, acc01); acc10 = MFMA16(a1, b0, acc10); acc11 = MFMA16(a1, b1, acc11);
        }
        LAS float* pw = PB + C.wave * 1024;
#pragma unroll
        for (int e = 0; e < 4; ++e) { pw[(4 * g + e) * 32 + r] = acc00[e]; pw[(4 * g + e) * 32 + 16 + r] = acc01[e]; pw[(16 + 4 * g + e) * 32 + r] = acc10[e]; pw[(16 + 4 * g + e) * 32 + 16 + r] = acc11[e]; }
        LDS_WAIT(); __syncthreads();
#pragma unroll
        for (int q = 0; q < 2; ++q) { const int idx = tid + 512 * q; float sum = 0.f;
#pragma unroll
            for (int w8 = 0; w8 < 8; ++w8) sum += PB[w8 * 1024 + idx];
            const int tk = idx >> 5; LR[idx] = sum * __builtin_amdgcn_rsqf((float)SSm[32 * tb + tk] * (1.0f / 1048576.0f) * (1.0f / DM) + EPS); }
        LDS_WAIT(); __syncthreads();
    }
    for (int tk4 = 0; tk4 < 4; ++tk4) {
        const int tl = 4 * C.wave + tk4, m = 32 * tb + tl;
        const bf16* prow = P + (size_t)m * NP; const int pos = m & (SEQ - 1);
        const f32x4 cs0 = rope[pos * 32 + 2 * j], cs1 = rope[pos * 32 + 2 * j + 1];
        v2u lo[8], hi[8];
#pragma unroll
        for (int it = 0; it < 8; ++it) { const int g = 4 * it + g4; lo[it] = *(const GAS v2u*)(prow + g * 128 + 4 * j); hi[it] = *(const GAS v2u*)(prow + g * 128 + 64 + 4 * j); }
#pragma unroll
        for (int it = 0; it < 8; ++it) {
            const int g = 4 * it + g4;
            f32x4 x = {bflo(lo[it].x), bfhi(lo[it].x), bflo(lo[it].y), bfhi(lo[it].y)}, y = {bflo(hi[it].x), bfhi(hi[it].x), bflo(hi[it].y), bfhi(hi[it].y)};
            const float ss = row16_sum(((x[0] * x[0] + x[1] * x[1]) + (x[2] * x[2] + x[3] * x[3])) + ((y[0] * y[0] + y[1] * y[1]) + (y[2] * y[2] + y[3] * y[3])));
            const float rstd = __builtin_amdgcn_rsqf(ss * (1.0f / 128.0f) + EPS);
            const bool isq = it < 4;
            x = x * rstd * (isq ? gq0 : gk0); y = y * rstd * (isq ? gq1 : gk1);
            const float ox0 = x[0] * cs0.x - y[0] * cs0.y, oy0 = y[0] * cs0.x + x[0] * cs0.y, ox1 = x[1] * cs0.z - y[1] * cs0.w, oy1 = y[1] * cs0.z + x[1] * cs0.w;
            const float ox2 = x[2] * cs1.x - y[2] * cs1.y, oy2 = y[2] * cs1.x + x[2] * cs1.y, ox3 = x[3] * cs1.z - y[3] * cs1.w, oy3 = y[3] * cs1.z + x[3] * cs1.w;
            bf16* dst = (isq ? QN + (size_t)m * 2048 + g * 128 : KN + (size_t)m * 2048 + (g - 16) * 128);
            *(GAS v2u*)(dst + 4 * j) = (v2u){pk2(ox0, ox1), pk2(ox2, ox3)}; *(GAS v2u*)(dst + 64 + 4 * j) = (v2u){pk2(oy0, oy1), pk2(oy2, oy3)};
        }
        float lr[32];
#pragma unroll
        for (int i = 0; i < 8; ++i) { const f32x4 t4 = *(const LAS f32x4*)(LR + tl * 32 + 4 * i); lr[4 * i] = t4[0]; lr[4 * i + 1] = t4[1]; lr[4 * i + 2] = t4[2]; lr[4 * i + 3] = t4[3]; }
#pragma unroll
        for (int dir = 0; dir < 2; ++dir) {
#pragma unroll
            for (int jj = 0; jj < 2; ++jj) { const int c = 4 * lane + 256 * jj; f32x4 z = *(const LAS f32x4*)(LW + 16384 + 512 * dir + c);
#pragma unroll
                for (int r = 0; r < 16; ++r) z = z + *(const LAS f32x4*)(LW + 8192 * dir + r * 512 + c) * lr[16 * dir + r];
                f32x4 o;
#pragma unroll
                for (int e = 0; e < 4; ++e) o[e] = (fminf(z[e], 0.0f) - __logf(1.0f + __expf(-fabsf(z[e])))) * (1.0f / 16.0f);
                *(GAS f32x4*)(GF + ((size_t)dir * M + m) * 512 + c) = o; asm volatile("" ::: "memory"); }
        }
#pragma unroll
        for (int dir = 0; dir < 2; ++dir) {
#pragma unroll
            for (int jj = 0; jj < 4; ++jj) { const int c = 4 * lane + 256 * jj; const v2u zw = *(const GAS v2u*)(prow + (dir ? P_HZB : P_HZF) + c);
                const f32x4 lb = *(const GAS f32x4*)(LB + (dir * NL + l) * 1024 + c); const f32x4 z = {bflo(zw.x), bfhi(zw.x), bflo(zw.y), bfhi(zw.y)};
                f32x4 o;
#pragma unroll
                for (int e = 0; e < 4; ++e) o[e] = __logf(fmaxf(lb[e], 1e-20f) + (1.0f - lb[e]) * sigm(z[e]));
                *(GAS f32x4*)(HF + ((size_t)dir * M + m) * 1024 + c) = o; }
        }
    }
    __syncthreads();
    }
}

__device__ __forceinline__ f32x4 ld4bf(const bf16* p) { const v2u w = *(const GAS v2u*)p; return (f32x4){bflo(w.x), bfhi(w.x), bflo(w.y), bfhi(w.y)}; }
__device__ __forceinline__ void post_phase(Ctx& C, int l) {
    const int lane = opaque_tid() & 63; unsigned char* ws = opaque_ws(C);
    const bf16* P = (const bf16*)(ws + WS_P);
    const bf16* O1 = (const bf16*)(ws + WS_O12); const bf16* O2 = O1 + (size_t)M * 2048;
    const bf16* SG0 = (const bf16*)(ws + WS_OSG); const bf16* SG1 = SG0 + (size_t)M * 1024;
    const bf16* SH0 = (const bf16*)(ws + WS_OSH); const bf16* SH1 = SH0 + (size_t)M * 1024;
    bf16* OC = (bf16*)(ws + WS_OA);
    const float* LAM = (const float*)(ws + WS_TAB + 65536);
    const float lam = LAM[2 * l], oml = LAM[2 * l + 1];
    const int g4 = lane >> 4, j = lane & 15;
    f32x4 ga[4], gg[4], gh[2];
#pragma unroll
    for (int i = 0; i < 4; ++i) { ga[i] = *(const GAS f32x4*)(C.in[9] + l * 256 + 64 * i + 4 * j); gg[i] = *(const GAS f32x4*)(C.in[14] + l * 256 + 64 * i + 4 * j); }
#pragma unroll
    for (int i = 0; i < 2; ++i) gh[i] = *(const GAS f32x4*)(C.in[17] + l * 128 + 64 * i + 4 * j);
    for (int m = opaque_gw(C); m < M; m += C.ngw) {
        const bf16* prow = P + (size_t)m * NP;
        f32x4 da[2][4];
#pragma unroll
        for (int it = 0; it < 2; ++it)
#pragma unroll
            for (int i = 0; i < 4; ++i) { const size_t o = (size_t)m * 2048 + (4 * it + g4) * 256 + 64 * i + 4 * j; da[it][i] = ld4bf(O1 + o) - ld4bf(O2 + o) * lam; }
        f32x4 dg[4]; v2u rg[4];
#pragma unroll
        for (int i = 0; i < 4; ++i) { const size_t o = (size_t)m * 1024 + g4 * 256 + 64 * i + 4 * j; dg[i] = ld4bf(SG0 + o) + ld4bf(SG1 + o); rg[i] = *(const GAS v2u*)(prow + P_GR + g4 * 256 + 64 * i + 4 * j); }
        f32x4 dh[2][2]; v2u rh[2][2];
#pragma unroll
        for (int it = 0; it < 2; ++it)
#pragma unroll
            for (int i = 0; i < 2; ++i) { const size_t o = (size_t)m * 1024 + (4 * it + g4) * 128 + 64 * i + 4 * j; dh[it][i] = ld4bf(SH0 + o) + ld4bf(SH1 + o);
                rh[it][i] = *(const GAS v2u*)(prow + P_HG + (4 * it + g4) * 128 + 64 * i + 4 * j); }
#pragma unroll
        for (int it = 0; it < 2; ++it) { float q = 0.f;
#pragma unroll
            for (int i = 0; i < 4; ++i) { const f32x4 d = da[it][i]; q += (d.x * d.x + d.y * d.y) + (d.z * d.z + d.w * d.w); }
            const float rstd = __builtin_amdgcn_rsqf(row16_sum(q) * (1.0f / 256.0f) + EPS) * oml;
#pragma unroll
            for (int i = 0; i < 4; ++i) { const f32x4 y = da[it][i] * rstd * ga[i]; *(GAS v2u*)(OC + (size_t)m * 4096 + (4 * it + g4) * 256 + 64 * i + 4 * j) = (v2u){pk2(y.x, y.y), pk2(y.z, y.w)}; } }
        { float q = 0.f;
#pragma unroll
            for (int i = 0; i < 4; ++i) { const f32x4 d = dg[i]; q += (d.x * d.x + d.y * d.y) + (d.z * d.z + d.w * d.w); }
            const float rstd = __builtin_amdgcn_rsqf(row16_sum(q) * (1.0f / 256.0f) + EPS);
#pragma unroll
            for (int i = 0; i < 4; ++i) { const f32x4 y = dg[i] * rstd * gg[i]; const float r0 = bflo(rg[i].x), r1 = bfhi(rg[i].x), r2 = bflo(rg[i].y), r3 = bfhi(rg[i].y);
                *(GAS v2u*)(OC + (size_t)m * 4096 + 2048 + g4 * 256 + 64 * i + 4 * j) = (v2u){pk2(y.x * r0 * sigm(r0), y.y * r1 * sigm(r1)), pk2(y.z * r2 * sigm(r2), y.w * r3 * sigm(r3))}; } }
#pragma unroll
        for (int it = 0; it < 2; ++it) { float q = 0.f;
#pragma unroll
            for (int i = 0; i < 2; ++i) { const f32x4 d = dh[it][i]; q += (d.x * d.x + d.y * d.y) + (d.z * d.z + d.w * d.w); }
            const float rstd = __builtin_amdgcn_rsqf(row16_sum(q) * (1.0f / 128.0f) + EPS);
#pragma unroll
            for (int i = 0; i < 2; ++i) { const f32x4 y = dh[it][i] * rstd * gh[i]; const float r0 = bflo(rh[it][i].x), r1 = bfhi(rh[it][i].x), r2 = bflo(rh[it][i].y), r3 = bfhi(rh[it][i].y);
                *(GAS v2u*)(OC + (size_t)m * 4096 + 3072 + (4 * it + g4) * 128 + 64 * i + 4 * j) = (v2u){pk2(y.x * r0 * sigm(r0), y.y * r1 * sigm(r1)), pk2(y.z * r2 * sigm(r2), y.w * r3 * sigm(r3))}; } }
    }
}

__device__ __forceinline__ sbf16x8 pack8(const f32x4 a, const f32x4 b) { v4u w = {pk2(a[0], a[1]), pk2(a[2], a[3]), pk2(b[0], b[1]), pk2(b[2], b[3])}; return __builtin_bit_cast(sbf16x8, w); }
__device__ __forceinline__ sbf16x8 cat64(const v2u lo, const v2u hi) { v4u w = {lo.x, lo.y, hi.x, hi.y}; return __builtin_bit_cast(sbf16x8, w); }
template <bool GLA>
__device__ __forceinline__ void scan_chain(Ctx& C, int b, int h, int dir) {
    constexpr int DV = GLA ? 256 : 128, NVJ = DV / 128, NVI = DV / 128;
    constexpr int CH = 32, NCH = SEQ / CH;
    constexpr int QI = 0, KI = 8704, KT = 17408, VT = 27648, GT = 48128, EL = 50176;
    const int tid = opaque_tid(), lane = tid & 63, r = lane & 15, g = lane >> 4, w = C.wave; unsigned char* ws = opaque_ws(C);
    const bf16* P = (const bf16*)(ws + WS_P);
    const int qcol = (GLA ? P_GQ : P_HQ) + h * 128, kcol = P_GK + h * 128, vcol = GLA ? (P_GV + h * 256) : (P_HI + h * 128), fld = GLA ? 512 : 1024;
    const float* gp = (const float*)(ws + (GLA ? WS_GF : WS_HF)) + (size_t)dir * M * fld + h * 128;
    bf16* op = (bf16*)(ws + (GLA ? WS_OSG : WS_OSH)) + (size_t)dir * M * 1024 + h * DV;
    LAS unsigned char* L = C.lds + RING_OFF;
    const size_t mb = (size_t)b * SEQ;
    const int ek = tid & 127, eg = tid >> 7;
    const int sv = GLA ? (tid & 255) : (tid & 127), sg0 = GLA ? (tid >> 8) : (tid >> 7);
#define CS_TOK(n, s) (dir ? (SEQ - 1 - (CH * (n) + (s))) : (CH * (n) + (s)))
    constexpr int RQ = 51200, RK = 59904, RV = 68608, RG = 85504;
    const int tt = tid >> 4, cc = tid & 15;
    v4u rq[2], rk[2], rv[2][NVI]; f32x4 rg[2][2];
#define CS_LOAD(hf, n) do { const size_t mrow = mb + CS_TOK(n, tt); rq[hf] = *(const GAS v4u*)(P + mrow * NP + qcol + 8 * cc); if (GLA) rk[hf] = *(const GAS v4u*)(P + mrow * NP + kcol + 8 * cc); \
        _Pragma("unroll") for (int i = 0; i < NVI; ++i) rv[hf][i] = *(const GAS v4u*)(P + mrow * NP + vcol + 128 * i + 8 * cc); \
        rg[hf][0] = *(const GAS f32x4*)(gp + mrow * fld + 8 * cc); rg[hf][1] = *(const GAS f32x4*)(gp + mrow * fld + 8 * cc + 4); } while (0)
#define CS_STAGE(hf) do { *(LAS v4u*)(L + RQ + tt * 272 + 16 * cc) = rq[hf]; if (GLA) *(LAS v4u*)(L + RK + tt * 272 + 16 * cc) = rk[hf]; \
        _Pragma("unroll") for (int i = 0; i < NVI; ++i) *(LAS v4u*)(L + RV + tt * 528 + 256 * i + 16 * cc) = rv[hf][i]; \
        *(LAS f32x4*)(L + RG + tt * 528 + 32 * cc) = rg[hf][0]; *(LAS f32x4*)(L + RG + tt * 528 + 32 * cc + 16) = rg[hf][1]; } while (0)
    f32x4 S[8][NVJ];
#pragma unroll
    for (int kt = 0; kt < 8; ++kt)
#pragma unroll
        for (int vj = 0; vj < NVJ; ++vj) S[kt][vj] = (f32x4){0.f, 0.f, 0.f, 0.f};
    CS_LOAD(0, 0); CS_LOAD(1, 1);
    CS_STAGE(0); LDS_WAIT(); __syncthreads();
    CS_LOAD(0, 2);
    for (int n2 = 0; n2 < NCH; n2 += 2) {
#pragma unroll
    for (int hf = 0; hf < 2; ++hf) { const int n = n2 + hf;
        float gl[8]; bf16 qv[8], kv[8], vv[NVI][8];
#pragma unroll
        for (int e = 0; e < 8; ++e) { gl[e] = *(const LAS float*)(L + RG + (8 * eg + e) * 528 + 4 * ek); qv[e] = *(const LAS unsigned short*)(L + RQ + (8 * eg + e) * 272 + 2 * ek);
            if (GLA) kv[e] = *(const LAS unsigned short*)(L + RK + (8 * eg + e) * 272 + 2 * ek); }
#pragma unroll
        for (int i = 0; i < NVI; ++i)
#pragma unroll
            for (int e = 0; e < 8; ++e) vv[i][e] = *(const LAS unsigned short*)(L + RV + (8 * (sg0 + 2 * i) + e) * 528 + 2 * sv);
        float c[8]; c[0] = gl[0];
#pragma unroll
        for (int e = 1; e < 8; ++e) c[e] = c[e - 1] + gl[e];
        *(LAS float*)(L + GT + (eg * 128 + ek) * 4) = c[7];
        LDS_WAIT(); __builtin_amdgcn_s_barrier(); asm volatile("" ::: "memory");
        float off = 0.f, glast = 0.f;
#pragma unroll
        for (int j = 0; j < 4; ++j) { const float t = *(const LAS float*)(L + GT + (j * 128 + ek) * 4); glast += t; off += (j < eg) ? t : 0.f; }
        f32x4 kh0, kh1; const float eL = __expf(glast);
#pragma unroll
        for (int e = 0; e < 8; ++e) {
            const float Gv = off + c[e];
            const float key = GLA ? bf1(kv[e]) : (1.0f - __expf(gl[e]));
            const float emG = __expf(fminf(-Gv, 80.0f));
            const float qt = bf1(qv[e]) * __expf(Gv), kt = key * emG, kh = kt * eL;
            *(LAS unsigned short*)(L + QI + (8 * eg + e) * 272 + 2 * ek) = (unsigned short)(pk2(qt, qt) & 0xffffu);
            *(LAS unsigned short*)(L + KI + (8 * eg + e) * 272 + 2 * ek) = (unsigned short)(pk2(kt, kt) & 0xffffu);
            if (e < 4) kh0[e] = kh; else kh1[e - 4] = kh;
        }
        *(LAS sbf16x8*)(L + KT + ek * 80 + 16 * eg) = pack8(kh0, kh1);
        if (eg == 0) *(LAS float*)(L + EL + ek * 4) = eL;
#pragma unroll
        for (int i = 0; i < NVI; ++i) { v4u wv; wv.x = (unsigned)vv[i][0] | ((unsigned)vv[i][1] << 16); wv.y = (unsigned)vv[i][2] | ((unsigned)vv[i][3] << 16);
            wv.z = (unsigned)vv[i][4] | ((unsigned)vv[i][5] << 16); wv.w = (unsigned)vv[i][6] | ((unsigned)vv[i][7] << 16);
            *(LAS v4u*)(L + VT + sv * 80 + 16 * (sg0 + 2 * i)) = wv; }
        if (n + 1 < NCH) CS_STAGE(hf ^ 1);
        LDS_WAIT(); __builtin_amdgcn_s_barrier(); asm volatile("" ::: "memory");
        if (n + 3 < NCH) CS_LOAD(hf ^ 1, n + 3);
        f32x4 AT00 = {0.f, 0.f, 0.f, 0.f}, AT01 = AT00, AT11 = AT00;
#pragma unroll
        for (int ks = 0; ks < 4; ++ks) {
            const sbf16x8 k0 = *(const LAS sbf16x8*)(L + KI + r * 272 + (32 * ks + 8 * g) * 2), k1 = *(const LAS sbf16x8*)(L + KI + (16 + r) * 272 + (32 * ks + 8 * g) * 2);
            const sbf16x8 q0 = *(const LAS sbf16x8*)(L + QI + r * 272 + (32 * ks + 8 * g) * 2), q1 = *(const LAS sbf16x8*)(L + QI + (16 + r) * 272 + (32 * ks + 8 * g) * 2);
            AT00 = MFMA16(k0, q0, AT00); AT01 = MFMA16(k0, q1, AT01); AT11 = MFMA16(k1, q1, AT11);
        }
#pragma unroll
        for (int e = 0; e < 4; ++e) { if (4 * g + e > r) { AT00[e] = 0.f; AT11[e] = 0.f; } }
        const f32x4 zero4 = {0.f, 0.f, 0.f, 0.f};
        const sbf16x8 PA0 = pack8(AT00, zero4), PA1 = pack8(AT01, AT11);
        f32x4 O[2][NVJ];
#pragma unroll
        for (int vj = 0; vj < NVJ; ++vj) {
            const int vrow = 16 * (NVJ * w + vj) + r;
            const sbf16x8 vperm = cat64(*(const LAS v2u*)(L + VT + vrow * 80 + 8 * g), *(const LAS v2u*)(L + VT + vrow * 80 + 32 + 8 * g));
            O[0][vj] = MFMA16(PA0, vperm, zero4); O[1][vj] = MFMA16(PA1, vperm, zero4);
        }
#pragma unroll
        for (int ks = 0; ks < 4; ++ks) {
            const sbf16x8 qp0 = cat64(*(const LAS v2u*)(L + QI + r * 272 + (32 * ks + 4 * g) * 2), *(const LAS v2u*)(L + QI + r * 272 + (32 * ks + 16 + 4 * g) * 2));
            const sbf16x8 qp1 = cat64(*(const LAS v2u*)(L + QI + (16 + r) * 272 + (32 * ks + 4 * g) * 2), *(const LAS v2u*)(L + QI + (16 + r) * 272 + (32 * ks + 16 + 4 * g) * 2));
#pragma unroll
            for (int vj = 0; vj < NVJ; ++vj) { const sbf16x8 sf = pack8(S[2 * ks][vj], S[2 * ks + 1][vj]);
                O[0][vj] = MFMA16(qp0, sf, O[0][vj]); O[1][vj] = MFMA16(qp1, sf, O[1][vj]); }
        }
#pragma unroll
        for (int tj = 0; tj < 2; ++tj)
#pragma unroll
            for (int vj = 0; vj < NVJ; ++vj)
#pragma unroll
                for (int e = 0; e < 4; ++e) { const float ov = O[tj][vj][e] * 0.088388347648318440f; op[(mb + CS_TOK(n, 16 * tj + 4 * g + e)) * 1024 + 16 * (NVJ * w + vj) + r] = (bf16)(pk2(ov, ov) & 0xffffu); }
#pragma unroll
        for (int kt = 0; kt < 8; ++kt) {
            const f32x4 dec = *(const LAS f32x4*)(L + EL + (16 * kt + 4 * g) * 4);
            const sbf16x8 kf = *(const LAS sbf16x8*)(L + KT + (16 * kt + r) * 80 + 16 * g);
#pragma unroll
            for (int vj = 0; vj < NVJ; ++vj) { const sbf16x8 vn = *(const LAS sbf16x8*)(L + VT + (16 * (NVJ * w + vj) + r) * 80 + 16 * g);
                S[kt][vj] = MFMA16(kf, vn, S[kt][vj] * dec); }
        }
    }
    }
    LDS_WAIT(); __syncthreads();
#undef CS_TOK
#undef CS_LOAD
#undef CS_STAGE
}
constexpr int CW_Q = 8192;
constexpr int CONV_CHUNK = 64;
static_assert(I_EARLY % CONV_CHUNK == 0 && I_LATE % CONV_CHUNK == 0, "conversion chunks");
__device__ __forceinline__ void mixer_phase(Ctx& C, int l, unsigned char* lds_generic) {
    unsigned char* ws = opaque_ws(C);
    const att::bf16* QN = (const att::bf16*)(ws + WS_QN); const att::bf16* KN = (const att::bf16*)(ws + WS_KN); const att::bf16* VN = (const att::bf16*)(ws + WS_VN);
    att::bf16* O12 = (att::bf16*)(ws + WS_O12);
    unsigned* qbase = (unsigned*)(ws + WS_CTL) + CW_Q + 64 * 8 * l;
    volatile LAS unsigned* slot = (volatile LAS unsigned*)(C.lds + MISC_OFF);
    const int x0 = (int)(xb_xcc_id() & 7u);
    for (int k = 0; k < 8; ++k) {
        const int x = (x0 + k) & 7;
        for (;;) {
            if (threadIdx.x == 0) slot[0] = __hip_atomic_fetch_add(qbase + 64 * x, 1u, __ATOMIC_RELAXED, __HIP_MEMORY_SCOPE_AGENT);
            __syncthreads();
            const int li = (int)__builtin_amdgcn_readfirstlane(slot[0]);
            __syncthreads();
            if (li >= 6 + 64) break;
            if (li < 6) { const int item = x + 8 * li;
                if (item < 16) scan_chain<true>(C, item >> 3, (item >> 1) & 3, item & 1);
                else { const int it = item - 16; scan_chain<false>(C, it >> 4, (it >> 1) & 7, it & 1); } }
            else {
                const int ul = li - 6, u = (x + 8 * (ul >> 4)) * 16 + (ul & 15), qb = u & 15, hm = (u >> 4) & 15, b = u >> 8;
                const size_t row0 = (size_t)b * SEQ;
                att::attn256_body(QN + (row0 + qb * 256) * 2048 + hm * 128, KN + row0 * 2048 + hm * 128, VN + row0 * 2048 + (hm >> 1) * 256,
                                  O12 + (size_t)(hm & 1) * M * 2048 + (row0 + qb * 256) * 2048 + (hm >> 1) * 256, SEQ, (char*)lds_generic + RING_OFF);
                __syncthreads();
            }
        }
    }
    {
        const int lane = opaque_tid() & 63; LAS float* scr = (LAS float*)(C.lds + RING_OFF + C.wave * 8448);
        unsigned* chead = (unsigned*)(ws + WS_CTL) + CW_Q + 64 * (8 * NL + l);
        const int nchunks = (I_LATE + (l + 1 < NL ? I_EARLY : 0)) / CONV_CHUNK;
        for (;;) {
            if (threadIdx.x == 0) slot[0] = __hip_atomic_fetch_add(chead, 1u, __ATOMIC_RELAXED, __HIP_MEMORY_SCOPE_AGENT);
            __syncthreads();
            const int ch = (int)__builtin_amdgcn_readfirstlane(slot[0]);
            __syncthreads();
            if (ch >= nchunks) break;
            for (int i = 0; i < CONV_CHUNK / NWAVES; ++i) { const int idx = ch * CONV_CHUNK + C.wave + NWAVES * i;
                if (idx < I_LATE) conv_item(C, ws, l, I_EARLY + idx, scr, lane); else conv_item(C, ws, l + 1, idx - I_LATE, scr, lane); }
        }
    }
}

struct Args { const float* in[25]; float* out; unsigned char* ws; int ph_lo, ph_hi; };
__global__ void __launch_bounds__(NWAVES * 64, 2) mk_fwd(Args args) {
    extern __shared__ __attribute__((aligned(16))) unsigned char lds[];
    Ctx C;
    C.lds = (LAS unsigned char*)lds;
    C.wave = __builtin_amdgcn_readfirstlane((int)threadIdx.x >> 6);
    C.G = gridDim.x; { const int bx = blockIdx.x; C.vcu = (C.G % 8 == 0) ? (bx % 8) * (C.G / 8) + bx / 8 : bx; }
    C.gw = C.vcu * NWAVES + C.wave; C.ngw = C.G * NWAVES;
    C.in = args.in; C.out = args.out; C.ws = args.ws;
    volatile LAS unsigned* MISC = (volatile LAS unsigned*)(C.lds + MISC_OFF);
    for (int u = threadIdx.x; u < (LDS_BYTES - LDSCTL_OFF) / 4; u += NWAVES * 64) ((LAS unsigned*)(C.lds + LDSCTL_OFF))[u] = 0u;
    __syncthreads();
    gu32* ctl = (gu32*)(C.ws + WS_CTL);
    XcdBarrier bar; bar.bar = (unsigned*)(ctl + CW_BAR); bar.x = 0; bar.st = nullptr;
    if (!MK_PER_PHASE) bar = xcd_barrier_post((unsigned*)(ctl + CW_BAR), MISC + 8);
    const int lo = args.ph_lo, hi = args.ph_hi;
    int ph = 0;
#ifndef REP_PRO
#define REP_PRO 1
#endif
#ifndef REP_THIN
#define REP_THIN 1
#endif
#ifndef REP_G4
#define REP_G4 1
#endif
#ifndef REP_G1
#define REP_G1 1
#endif
#ifndef REP_G3
#define REP_G3 1
#endif
#ifndef REP_ATT
#define REP_ATT 1
#endif
#ifndef REP_SCAN
#define REP_SCAN 1
#endif
#ifndef MK_SITES
#define MK_SITES 0xffffffffu
#endif
#define SITE(k) (((MK_SITES) >> (k)) & 1u)
#define PH_ON (lo <= ph && ph < hi)
#define PH_END do { if (!MK_PER_PHASE && lo <= ph && ph + 1 < hi) { XcdBarrier b2 = bar; asm volatile("" : "+s"(b2.bar), "+s"(b2.x)); xcd_barrier(b2); } ++ph; } while (0)

    if (SITE(0) && PH_ON) for (int rep = 0; rep < REP_PRO; ++rep) prologue(C);
    PH_END;

    for (int l = 0; l < NL; ++l) {
#define WL(ws) ((const bf16*)((ws) + WS_W) + (size_t)l * LAYER_W)
        if (SITE(2) && PH_ON) for (int rep = 0; rep < REP_G1; ++rep) { unsigned char* ws = opaque_ws(C); pg8::Gemm g{(const bf16*)(ws + WS_H), WL(ws) + OW_1A, M, 2 * FF, DM}; pg8::StaticOrder S; S.init(M, 2 * FF, C.G, (int)blockIdx.x);
            pg8::EpiGlu E{(bf16*)(ws + WS_ACT), FF, (const unsigned long long*)(ws + WS_SS) + (size_t)(3 * l) * M, 1.0f / DM, EPS};
            pg8::gemm_phase<pg8::EpiGlu, pg8::StaticOrder, true, true>(C.lds + RING_OFF, g, S, E); }
        PH_END;
        if (SITE(3) && PH_ON) { unsigned char* ws = opaque_ws(C); pg8::Gemm g{(const bf16*)(ws + WS_ACT), WL(ws) + OW_1B, M, DM, FF}; pg8::StaticOrder S; S.init(M, DM, C.G, (int)blockIdx.x);
            pg8::EpiResid<false, false, true> E{nullptr, nullptr, (bf16*)(ws + WS_H), (unsigned long long*)(ws + WS_SS) + (size_t)(3 * l + 1) * M, DM, 0.5f, ws + WS_X8};
            pg8::gemm_phase<pg8::EpiResid<false, false, true>, pg8::StaticOrder, true, true>(C.lds + RING_OFF, g, S, E); }
        PH_END;
        if (SITE(5) && PH_ON) for (int rep = 0; rep < REP_G3; ++rep) {
            { unsigned char* ws = opaque_ws(C); pg8::Gemm g{(const bf16*)(ws + WS_H), WL(ws) + OW_IN, M, P_GA, DM}; pg8::StaticOrder S; S.init(M, P_GA, C.G, (int)blockIdx.x);
              pg8::EpiBf16Plain E{(bf16*)(ws + WS_P), NP, (const unsigned long long*)(ws + WS_SS) + (size_t)(3 * l + 1) * M, 1.0f / DM, EPS, (bf16*)(ws + WS_VN), 2048, P_AV / 256, P_GQ / 256, 1.0f};
              pg8::gemm_phase<pg8::EpiBf16Plain, pg8::StaticOrder, true, true>(C.lds + RING_OFF, g, S, E); }
            { unsigned char* ws = opaque_ws(C); pg8::Gemm g{(const bf16*)(ws + WS_X8), WL(ws) + OW_IN + OW8_OFF, M, NP - P_GA, DM / 2}; pg8::StaticOrder S; S.init(M, NP - P_GA, C.G, (int)blockIdx.x);
              pg8::EpiBf16Plain E{(bf16*)(ws + WS_P) + P_GA, NP, (const unsigned long long*)(ws + WS_SS) + (size_t)(3 * l + 1) * M, 1.0f / DM, EPS, nullptr, 0, 0, 0, 1.0f / W8_SCALE};
              pg8::gemm_phase<pg8::EpiBf16Plain, pg8::StaticOrder, true, true, true>(C.lds + RING_OFF, g, S, E); } }
        PH_END;
        if (SITE(6) && PH_ON) for (int rep = 0; rep < REP_THIN; ++rep) prep_phase(C, l);
        PH_END;
        if (SITE(7) && PH_ON) mixer_phase(C, l, lds);
        PH_END;
        if (SITE(8) && PH_ON) for (int rep = 0; rep < REP_THIN; ++rep) post_phase(C, l);
        PH_END;
        if (SITE(9) && PH_ON) for (int rep = 0; rep < REP_G4; ++rep) { unsigned char* ws = opaque_ws(C); pg8::Gemm g{(const bf16*)(ws + WS_OA), WL(ws) + OW_A, M, DM, DM}; pg8::StaticOrder S; S.init(M, DM, C.G, (int)blockIdx.x);
            pg8::EpiGate3 E{(const bf16*)(ws + WS_P) + P_GA, NP, P_GG - P_GA, P_GH - P_GA, (bf16*)(ws + WS_MB), DM, 2048 / 64, 3072 / 64};
            pg8::gemm_phase<pg8::EpiGate3, pg8::StaticOrder, true, true>(C.lds + RING_OFF, g, S, E); }
        PH_END;
        if (SITE(10) && PH_ON) { unsigned char* ws = opaque_ws(C); pg8::Gemm g{(const bf16*)(ws + WS_MB), WL(ws) + OW_O, M, DM, DM}; pg8::StaticOrder S; S.init(M, DM, C.G, (int)blockIdx.x);
            pg8::EpiResid<false, false> E{nullptr, nullptr, (bf16*)(ws + WS_H), (unsigned long long*)(ws + WS_SS) + (size_t)(3 * l + 2) * M, DM, 1.0f};
            pg8::gemm_phase<pg8::EpiResid<false, false>, pg8::StaticOrder, true, true>(C.lds + RING_OFF, g, S, E); }
        PH_END;
        if (SITE(12) && PH_ON) for (int rep = 0; rep < REP_G1; ++rep) { unsigned char* ws = opaque_ws(C); pg8::Gemm g{(const bf16*)(ws + WS_H), WL(ws) + OW_2A, M, 2 * FF, DM}; pg8::StaticOrder S; S.init(M, 2 * FF, C.G, (int)blockIdx.x);
            pg8::EpiGlu E{(bf16*)(ws + WS_ACT), FF, (const unsigned long long*)(ws + WS_SS) + (size_t)(3 * l + 2) * M, 1.0f / DM, EPS};
            pg8::gemm_phase<pg8::EpiGlu, pg8::StaticOrder, true, true>(C.lds + RING_OFF, g, S, E); }
        PH_END;
        if (SITE(13) && PH_ON) { unsigned char* ws = opaque_ws(C); pg8::Gemm g{(const bf16*)(ws + WS_ACT), WL(ws) + OW_2B, M, DM, FF}; pg8::StaticOrder S; S.init(M, DM, C.G, (int)blockIdx.x);
            if (l + 1 < NL) { pg8::EpiResid<false, false> E{nullptr, nullptr, (bf16*)(ws + WS_H), (unsigned long long*)(ws + WS_SS) + (size_t)(3 * l + 3) * M, DM, 0.5f};
                pg8::gemm_phase<pg8::EpiResid<false, false>, pg8::StaticOrder, true, true>(C.lds + RING_OFF, g, S, E); }
            else { pg8::EpiResid<false, true> E{nullptr, C.out, (bf16*)(ws + WS_H), nullptr, DM, 0.5f};
                pg8::gemm_phase<pg8::EpiResid<false, true>, pg8::StaticOrder, true, true>(C.lds + RING_OFF, g, S, E); } }
        PH_END;
#undef WL
    }
#undef PH_ON
#undef PH_END
}
constexpr int N_PHASES = 1 + 10 * NL;

extern "C" void kernel_launch(void* const* d_in, const int* in_sizes, int n_in, void* d_out, int out_size, void* d_ws, size_t ws_size, hipStream_t stream) {
    static int grid = 0;
    if (grid == 0) {
        if (n_in != 25 || in_sizes[0] != M * DM || out_size != M * DM || ws_size < WS_END) {
            fprintf(stderr, "kernel_launch: built for 25 inputs, x/out of %d floats, >= %zu bytes of workspace; got n_in %d, in0 %d, out %d, ws %zu; nothing launched\n", M * DM, (size_t)WS_END, n_in, n_in > 0 ? in_sizes[0] : -1, out_size, ws_size);
            grid = -1; return; }
        int dev = 0, cus = 0, per_cu = 0;
        if (hipGetDevice(&dev) != hipSuccess || hipDeviceGetAttribute(&cus, hipDeviceAttributeMultiprocessorCount, dev) != hipSuccess) { fprintf(stderr, "kernel_launch: device query failed\n"); grid = -1; return; }
        if (hipFuncSetAttribute((const void*)mk_fwd, hipFuncAttributeMaxDynamicSharedMemorySize, LDS_BYTES) != hipSuccess) { fprintf(stderr, "kernel_launch: hipFuncSetAttribute failed\n"); grid = -1; return; }
        if (hipOccupancyMaxActiveBlocksPerMultiprocessor(&per_cu, (const void*)mk_fwd, NWAVES * 64, LDS_BYTES) != hipSuccess || per_cu < 1)
            fprintf(stderr, "kernel_launch: note: occupancy query reports %d workgroups per CU\n", per_cu);
        (void)hipGetLastError();
        grid = cus;
    }
    if (grid < 0) return;
    if (hipMemsetAsync((char*)d_ws + WS_CTL, 0, CTL_ZERO_BYTES, stream) != hipSuccess) { fprintf(stderr, "kernel_launch: memset failed\n"); return; }
    Args a{};
    for (int i = 0; i < 25; ++i) a.in[i] = (const float*)d_in[i];
    a.out = (float*)d_out; a.ws = (unsigned char*)d_ws;
#if MK_PER_PHASE
    for (int p = 0; p < N_PHASES; ++p) { a.ph_lo = p; a.ph_hi = p + 1; hipLaunchKernelGGL(mk_fwd, dim3(grid), dim3(NWAVES * 64), LDS_BYTES, stream, a); }
#else
    a.ph_lo = 0; a.ph_hi = N_PHASES;
    hipLaunchKernelGGL(mk_fwd, dim3(grid), dim3(NWAVES * 64), LDS_BYTES, stream, a);
#endif
    const hipError_t le = hipPeekAtLastError();
    if (le != hipSuccess) fprintf(stderr, "kernel_launch: launch failed: %s\n", hipGetErrorName(le));
}
```
